# Optimizing an MI355X kernel written in HIP

```python
import math
import jax
import jax.numpy as jnp
from jax import lax
import numpy as np

D_MODEL = 2048
BATCH = 4
SEQ = 2048
DEPTH = 1
DEC_BATCH = 8
DEC_SEQ = 8
PAST_LEN = 16384
PAGE_SIZE = 128

HG_HEADS = 8
HG_DK = 128
HG_DV = 128
HG_WIDTH = HG_HEADS * HG_DV
HG_CHUNK = 64
DA_HEADS = 8
DA_DH = 64
DA_DV = 2 * DA_DH
DA_WIDTH = DA_HEADS * DA_DV
N_BUCKETS = 32
REL_MAX_DISTANCE = 128
Q_BLOCK = 128
D_FF = ((8 * D_MODEL // 3 + 255) // 256) * 256
RMS_EPS = 1e-6
NEG_INF = -1e30

_IN_SIZES = (HG_HEADS * HG_DK, HG_HEADS * HG_DK, HG_WIDTH, HG_WIDTH,
             2 * DA_HEADS * DA_DH, 2 * DA_HEADS * DA_DH, DA_WIDTH, D_MODEL, D_MODEL)
IN_SPLIT_POINTS = tuple(int(s) for s in np.cumsum(_IN_SIZES)[:-1])
N_IN = int(sum(_IN_SIZES))

kernel_name = 'hgrn2_diffattn_gated_hybrid_step'


def rms_norm(x, w):
    xf = x.astype(jnp.float32)
    y = xf * lax.rsqrt(jnp.mean(xf * xf, axis=-1, keepdims=True) + RMS_EPS)
    return (y * w.astype(jnp.float32)).astype(x.dtype)


def t5_bucket(dist):
    n = jnp.maximum(dist, 0)
    max_exact = N_BUCKETS // 2
    nf = jnp.maximum(n, 1).astype(jnp.float32)
    large = max_exact + (jnp.log(nf / max_exact) / math.log(REL_MAX_DISTANCE / max_exact)
                         * (N_BUCKETS - max_exact)).astype(jnp.int32)
    large = jnp.minimum(large, N_BUCKETS - 1)
    return jnp.where(n < max_exact, n, large)


def diff_attend(q, k, v, q_pos, k_pos, bias_table, lam):
    b, lq = q.shape[:2]
    lk = k.shape[1]
    s = jnp.einsum('bqhd,bkhd->bhqk', q.astype(jnp.float32), k.astype(jnp.float32)) * (DA_DH ** -0.5)
    bucket = t5_bucket(q_pos[:, None] - k_pos[None, :])
    s = s + jnp.transpose(bias_table.astype(jnp.float32)[bucket], (2, 0, 1))[None]
    s = jnp.where((k_pos[None, :] <= q_pos[:, None])[None, None], s, NEG_INF)
    p = jax.nn.softmax(s, axis=-1).reshape(b, 2, DA_HEADS, lq, lk)
    pd = p[:, 0] - lam * p[:, 1]
    return jnp.einsum('bhqk,bkhv->bqhv', pd, v.astype(jnp.float32))


def attend_prompt(q, k, v, bias_table, lam):
    b, L = q.shape[:2]
    nb = L // Q_BLOCK
    pos = jnp.arange(L, dtype=jnp.int32)
    kf = k.astype(jnp.float32)
    vf = v.astype(jnp.float32)
    qb = jnp.moveaxis(q.reshape(b, nb, Q_BLOCK, 2 * DA_HEADS, DA_DH), 1, 0)
    pb = pos.reshape(nb, Q_BLOCK)
    o = lax.map(lambda a: diff_attend(a[0], kf, vf, a[1], pos, bias_table, lam), (qb, pb))
    return jnp.moveaxis(o, 0, 1).reshape(b, L, DA_HEADS, DA_DV)


def hgrn2_recurrence(q, f_logit, i, lb, s0):
    b, L, H, dk = q.shape
    dv = i.shape[-1]
    f = lb + (1.0 - lb) * jax.nn.sigmoid(f_logit.astype(jnp.float32))
    g = jnp.log(f)
    kin = 1.0 - f
    c = min(HG_CHUNK, L)
    pad = (-L) % c
    n = (L + pad) // c

    def blk(t):
        t = jnp.pad(t, ((0, 0), (0, pad), (0, 0), (0, 0)))
        return t.reshape(b, n, c, H, t.shape[-1]).transpose(0, 3, 1, 2, 4)

    qc = blk(q.astype(jnp.float32))
    kc = blk(kin)
    vc = blk(i.astype(jnp.float32))
    G = jnp.cumsum(blk(g), axis=3)
    qg = qc * jnp.exp(G)
    kg = kc * jnp.exp(-G)
    causal = jnp.tril(jnp.ones((c, c), dtype=bool))
    A = jnp.where(causal, jnp.einsum('bhncd,bhnsd->bhncs', qg, kg), 0.0)
    o_intra = jnp.einsum('bhncs,bhnsv->bhncv', A, vc)
    G_last = G[:, :, :, -1]
    dS = jnp.einsum('bhncd,bhncv->bhndv', kc * jnp.exp(G_last[:, :, :, None, :] - G), vc)
    decay = jnp.exp(G_last)

    def step(S, xs):
        d, ds = xs
        return d[..., None] * S + ds, S

    s_final, s_prev = lax.scan(step, s0.astype(jnp.float32),
                               (jnp.moveaxis(decay, 2, 0), jnp.moveaxis(dS, 2, 0)))
    o_inter = jnp.einsum('bhncd,nbhdv->bhncv', qg, s_prev)
    o = (o_intra + o_inter).transpose(0, 2, 3, 1, 4).reshape(b, n * c, H, dv)[:, :L]
    return o, s_final.astype(s0.dtype)


def decoder_layer(x, l, s0, past_k, past_v, params):
    (norm_mix_pre, norm_mix_post, norm_ffn_pre, norm_ffn_post, w_in, hg_lb_logits, hg_norm_w,
     lq1, lk1, lq2, lk2, da_subln_w, rel_bias_table, w_branch_hg, w_branch_da, w_out,
     w_ffn_up, w_ffn_down) = params
    b, L, _ = x.shape
    h = rms_norm(x, norm_mix_pre[l])
    u = h @ w_in[l]
    hq, hf, hi, hgate, dq, dk, dv, g_hg, g_da = jnp.split(u, IN_SPLIT_POINTS, axis=-1)

    lb = jnp.cumsum(jax.nn.softmax(hg_lb_logits.astype(jnp.float32), axis=0), axis=0)[l]
    lb = lb.reshape(HG_HEADS, HG_DK)
    o_hg, s_new = hgrn2_recurrence(hq.reshape(b, L, HG_HEADS, HG_DK), hf.reshape(b, L, HG_HEADS, HG_DK),
                                   hi.reshape(b, L, HG_HEADS, HG_DV), lb, s0)
    o_hg = rms_norm(o_hg.astype(x.dtype), hg_norm_w[l]) * jax.nn.silu(hgate.reshape(b, L, HG_HEADS, HG_DV))
    y_hg = o_hg.reshape(b, L, HG_WIDTH) @ w_branch_hg[l]

    q = dq.reshape(b, L, 2 * DA_HEADS, DA_DH)
    k = dk.reshape(b, L, 2 * DA_HEADS, DA_DH)
    v = dv.reshape(b, L, DA_HEADS, DA_DV)
    lam_init = 0.8 - 0.6 * math.exp(-0.3 * l)
    lam = (jnp.exp(jnp.sum(lq1[l].astype(jnp.float32) * lk1[l].astype(jnp.float32)))
           - jnp.exp(jnp.sum(lq2[l].astype(jnp.float32) * lk2[l].astype(jnp.float32))) + lam_init)
    if past_k is None:
        o_da = attend_prompt(q, k, v, rel_bias_table, lam)
    else:
        past_len = past_k.shape[1]
        k_all = jnp.concatenate([past_k, k.astype(past_k.dtype)], axis=1)
        v_all = jnp.concatenate([past_v, v.astype(past_v.dtype)], axis=1)
        q_pos = past_len + jnp.arange(L, dtype=jnp.int32)
        k_pos = jnp.arange(past_len + L, dtype=jnp.int32)
        o_da = diff_attend(q, k_all, v_all, q_pos, k_pos, rel_bias_table, lam)
    o_da = rms_norm(o_da.astype(x.dtype), da_subln_w[l]) * (1.0 - lam_init)
    y_da = o_da.reshape(b, L, DA_WIDTH) @ w_branch_da[l]

    mixed = (jax.nn.sigmoid(g_hg) * y_hg + jax.nn.sigmoid(g_da) * y_da) @ w_out[l]
    x = x + rms_norm(mixed, norm_mix_post[l])

    h = rms_norm(x, norm_ffn_pre[l])
    gate, up = jnp.split(h @ w_ffn_up[l], 2, axis=-1)
    ffn = (jax.nn.silu(gate) * up) @ w_ffn_down[l]
    x = x + rms_norm(ffn, norm_ffn_post[l])
    return x, k, v, s_new


def setup_inputs(seed: int = 0) -> dict:
    key = jax.random.key(seed)
    ks = jax.random.split(key, 26)
    n_pages = PAST_LEN // PAGE_SIZE
    n_used = DEC_BATCH * n_pages
    n_pool = n_used + max(1, n_used // 4)
    f32 = jnp.float32

    def nrm(k, shape, scale):
        return jax.random.normal(k, shape, f32) * scale

    def gain(k, shape):
        return 1.0 + 0.02 * jax.random.normal(k, shape, f32)

    page_table = jax.random.permutation(ks[5], n_pool)[:n_used].reshape(DEC_BATCH, n_pages).astype(jnp.int32)
    return {
        'x_prompt': nrm(ks[0], (BATCH, SEQ, D_MODEL), 1.0),
        'x_sample': nrm(ks[1], (DEC_BATCH, DEC_SEQ, D_MODEL), 1.0),
        'cache_k': nrm(ks[2], (DEPTH, n_pool, PAGE_SIZE, 2 * DA_HEADS, DA_DH), 1.0),
        'cache_v': nrm(ks[3], (DEPTH, n_pool, PAGE_SIZE, DA_HEADS, DA_DV), 1.0),
        'state_hgrn': nrm(ks[4], (DEPTH, DEC_BATCH, HG_HEADS, HG_DK, HG_DV), 0.5),
        'page_table': page_table,
        'norm_mix_pre': gain(ks[6], (DEPTH, D_MODEL)),
        'norm_mix_post': gain(ks[7], (DEPTH, D_MODEL)),
        'norm_ffn_pre': gain(ks[8], (DEPTH, D_MODEL)),
        'norm_ffn_post': gain(ks[9], (DEPTH, D_MODEL)),
        'w_in': nrm(ks[10], (DEPTH, D_MODEL, N_IN), D_MODEL ** -0.5),
        'hg_lb_logits': nrm(ks[11], (DEPTH + 1, HG_HEADS * HG_DK), 0.1),
        'hg_norm_w': gain(ks[12], (DEPTH, HG_DV)),
        'da_lambda_q1': nrm(ks[13], (DEPTH, DA_DH), 0.1),
        'da_lambda_k1': nrm(ks[14], (DEPTH, DA_DH), 0.1),
        'da_lambda_q2': nrm(ks[15], (DEPTH, DA_DH), 0.1),
        'da_lambda_k2': nrm(ks[16], (DEPTH, DA_DH), 0.1),
        'da_subln_w': gain(ks[17], (DEPTH, DA_DV)),
        'rel_bias_table': nrm(ks[18], (N_BUCKETS, 2 * DA_HEADS), 0.5),
        'w_branch_hg': nrm(ks[19], (DEPTH, HG_WIDTH, D_MODEL), HG_WIDTH ** -0.5),
        'w_branch_da': nrm(ks[20], (DEPTH, DA_WIDTH, D_MODEL), DA_WIDTH ** -0.5),
        'w_out': nrm(ks[21], (DEPTH, D_MODEL, D_MODEL), D_MODEL ** -0.5),
        'w_ffn_up': nrm(ks[22], (DEPTH, D_MODEL, 2 * D_FF), D_MODEL ** -0.5),
        'w_ffn_down': nrm(ks[23], (DEPTH, D_FF, D_MODEL), D_FF ** -0.5),
    }


def reference(x_prompt, x_sample, cache_k, cache_v, state_hgrn, page_table, norm_mix_pre, norm_mix_post,
              norm_ffn_pre, norm_ffn_post, w_in, hg_lb_logits, hg_norm_w, da_lambda_q1, da_lambda_k1,
              da_lambda_q2, da_lambda_k2, da_subln_w, rel_bias_table, w_branch_hg, w_branch_da, w_out,
              w_ffn_up, w_ffn_down):
    params = (norm_mix_pre, norm_mix_post, norm_ffn_pre, norm_ffn_post, w_in, hg_lb_logits, hg_norm_w,
              da_lambda_q1, da_lambda_k1, da_lambda_q2, da_lambda_k2, da_subln_w, rel_bias_table,
              w_branch_hg, w_branch_da, w_out, w_ffn_up, w_ffn_down)
    n_seq, n_pages = page_table.shape
    past_len = n_pages * cache_k.shape[2]
    y_p = x_prompt
    y_s = x_sample
    kp_l, vp_l, sp_l, ks_l, vs_l, ss_l = [], [], [], [], [], []
    for l in range(DEPTH):
        s0 = jnp.zeros((x_prompt.shape[0], HG_HEADS, HG_DK, HG_DV), state_hgrn.dtype)
        y_p, kp, vp, sp = decoder_layer(y_p, l, s0, None, None, params)
        past_k = cache_k[l][page_table].reshape(n_seq, past_len, 2 * DA_HEADS, DA_DH)
        past_v = cache_v[l][page_table].reshape(n_seq, past_len, DA_HEADS, DA_DV)
        y_s, ks_, vs_, ss_ = decoder_layer(y_s, l, state_hgrn[l], past_k, past_v, params)
        kp_l.append(kp)
        vp_l.append(vp)
        sp_l.append(sp)
        ks_l.append(ks_)
        vs_l.append(vs_)
        ss_l.append(ss_)
    return (y_p, y_s, jnp.stack(kp_l), jnp.stack(vp_l), jnp.stack(sp_l),
            jnp.stack(ks_l), jnp.stack(vs_l), jnp.stack(ss_l))
```

```cpp
#include <hip/hip_runtime.h>
#include <cstdio>
#include <cstdint>
namespace pg8 {
#define PG8_LAS __attribute__((address_space(3)))
typedef unsigned short bf16_t;
typedef short bf16x8 __attribute__((ext_vector_type(8)));
typedef float f32x4 __attribute__((ext_vector_type(4)));
typedef unsigned u32x4 __attribute__((ext_vector_type(4)));
constexpr int BM = 256, BK = 64, HALF = 128, HTB = HALF * BK * 2  , STAGE_BYTES = 8 * HTB, NXCD = 8, WGM = 8;

__host__ __device__ __forceinline__ int lds_byte(int r, int c) { const int st = (r >> 4) * 2 + (c >> 5), rr = r & 15, cc = c & 31, ob = rr * 64 + cc * 2; return st * 1024 + (ob ^ (((ob >> 9) & 1) << 5)); }
__host__ __device__ __forceinline__ void stage_rc(int b, int& R, int& C) { const int st = b / 1024, sb = b % 1024, swz = sb ^ (((sb >> 9) & 1) << 5); R = (st >> 1) * 16 + swz / 64; C = (st & 1) * 32 + (swz % 64) / 2; }
__host__ __device__ __forceinline__ int perm32(int rho) { const int n = rho >> 4, i = rho & 15; return 8 * (i >> 2) + 4 * n + (i & 3); }

struct Unit { int pm, pn; };
struct Gemm { const bf16_t* A; const bf16_t* Bt; int M, N, K; };

struct StaticOrder {
    int nM, nN, nwg, G, c;
    __host__ __device__ void init(int M, int N, int G_, int c_) { nM = M / BM; nN = N / BM; nwg = nM * nN; G = G_; c = c_; }
    __host__ __device__ bool next(int i, Unit& u) const {
        const long L = (long)i * G + c; if (L >= nwg) return false;
        int wgid = (int)L; { const int q = nwg / NXCD, r = nwg % NXCD, xcd = wgid % NXCD, off = wgid / NXCD; wgid = (xcd < r ? xcd * (q + 1) : r * (q + 1) + (xcd - r) * q) + off; }
        const int nig = WGM * nN, gid = wgid / nig, fm = gid * WGM, gsz = (nM - fm) < WGM ? (nM - fm) : WGM;
        u.pm = fm + ((wgid % nig) % gsz); u.pn = (wgid % nig) / gsz; return true;
    }
    __device__ __forceinline__ void a_ready(const Unit&) const {}
    __device__ __forceinline__ void done(const Unit&) const {}
};

__device__ __forceinline__ unsigned cvt_pk_bf16(float lo, float hi) { unsigned r; asm volatile("v_cvt_pk_bf16_f32 %0, %1, %2" : "=v"(r) : "v"(lo), "v"(hi)); return r; }
__device__ __forceinline__ float bf2f(unsigned short h) { return __uint_as_float((unsigned)h << 16); }
__device__ __forceinline__ float sigmoidf_(float x) { return 1.0f / (1.0f + __expf(-x)); }
__device__ __forceinline__ u32x4 pack8(const f32x4 a, const f32x4 b) { u32x4 w; w.x = cvt_pk_bf16(a[0], a[1]); w.y = cvt_pk_bf16(a[2], a[3]); w.z = cvt_pk_bf16(b[0], b[1]); w.w = cvt_pk_bf16(b[2], b[3]); return w; }
__device__ __forceinline__ void unpack8(const u32x4 w, f32x4& a, f32x4& b) {
    a[0] = __uint_as_float(w.x << 16); a[1] = __uint_as_float(w.x & 0xffff0000u); a[2] = __uint_as_float(w.y << 16); a[3] = __uint_as_float(w.y & 0xffff0000u);
    b[0] = __uint_as_float(w.z << 16); b[1] = __uint_as_float(w.z & 0xffff0000u); b[2] = __uint_as_float(w.w << 16); b[3] = __uint_as_float(w.w & 0xffff0000u); }

struct EpiInProj {
    static constexpr bool PERM = true, AFTER_DRAIN = false;
    bf16_t* U; float* G; float* out_kp; float* out_vp; float* out_ks; float* out_vs; const float* lbl; int n_in, mp, mreal; float qscale;
    __device__ __forceinline__ void operator()(const f32x4 (&acc)[2][2][4][2], const Unit& u, int wr, int wc, int fr, int fq) const {
        const int pn = u.pn, row0 = u.pm * BM + wr * 64 + fr, colb = pn * BM + wc * 32 + 8 * fq;
        const int grp = pn >> 2;
        if (grp == 1) {
            float lb[2][8];
#pragma unroll
            for (int bj = 0; bj < 2; ++bj)
#pragma unroll
                for (int e = 0; e < 8; ++e) { const int c = colb + bj * HALF + e - 1024; const float l0 = lbl[c], l1 = lbl[1024 + c]; lb[bj][e] = 1.0f / (1.0f + expf(l1 - l0)); }
#pragma unroll
            for (int ai = 0; ai < 2; ++ai)
#pragma unroll
                for (int m = 0; m < 4; ++m) { const size_t row = (size_t)(row0 + ai * HALF + m * 16);
#pragma unroll
                    for (int bj = 0; bj < 2; ++bj) { f32x4 v0 = acc[ai][bj][m][0], v1 = acc[ai][bj][m][1];
#pragma unroll
                        for (int e = 0; e < 4; ++e) { v0[e] = logf(lb[bj][e] + (1.0f - lb[bj][e]) / (1.0f + expf(-v0[e]))); v1[e] = logf(lb[bj][4 + e] + (1.0f - lb[bj][4 + e]) / (1.0f + expf(-v1[e]))); }
                        float* gp = G + row * 1024 + (colb + bj * HALF - 1024); *(f32x4*)gp = v0; *(f32x4*)(gp + 4) = v1; } }
            return;
        }
#pragma unroll
        for (int ai = 0; ai < 2; ++ai)
#pragma unroll
            for (int m = 0; m < 4; ++m) { const int row = row0 + ai * HALF + m * 16;
#pragma unroll
                for (int bj = 0; bj < 2; ++bj) { f32x4 v0 = acc[ai][bj][m][0], v1 = acc[ai][bj][m][1]; const int col = colb + bj * HALF;
                    if (grp == 5 || grp == 6) {
                        float* o = nullptr;
                        if (row < mp) o = (grp == 5 ? out_kp : out_vp) + (size_t)row * 1024; else if (row < mreal) o = (grp == 5 ? out_ks : out_vs) + (size_t)(row - mp) * 1024;
                        if (o) { o += col - (grp == 5 ? 5120 : 6144); *(f32x4*)o = v0; *(f32x4*)(o + 4) = v1; }
                    } else if (grp == 3) {
#pragma unroll
                        for (int e = 0; e < 4; ++e) { v0[e] = v0[e] * sigmoidf_(v0[e]); v1[e] = v1[e] * sigmoidf_(v1[e]); }
                    } else if (grp == 4) { v0 = v0 * qscale; v1 = v1 * qscale; }
                    else if (grp >= 7) {
#pragma unroll
                        for (int e = 0; e < 4; ++e) { v0[e] = sigmoidf_(v0[e]); v1[e] = sigmoidf_(v1[e]); }
                    }
                    *(u32x4*)(U + (size_t)row * n_in + col) = pack8(v0, v1); } }
    }
};
struct EpiBranchA {
    static constexpr bool PERM = true, AFTER_DRAIN = false;
    const bf16_t* SG; int ldsg; float* T1;
    __device__ __forceinline__ void operator()(const f32x4 (&acc)[2][2][4][2], const Unit& u, int wr, int wc, int fr, int fq) const {
        const int row0 = u.pm * BM + wr * 64 + fr, colb = u.pn * BM + wc * 32 + 8 * fq;
#pragma unroll
        for (int ai = 0; ai < 2; ++ai)
#pragma unroll
            for (int m = 0; m < 4; ++m) { const size_t row = (size_t)(row0 + ai * HALF + m * 16);
#pragma unroll
                for (int bj = 0; bj < 2; ++bj) { const int col = colb + bj * HALF; f32x4 g0, g1; unpack8(*(const u32x4*)(SG + row * ldsg + col), g0, g1);
                    float* t = T1 + row * 2048 + col; *(f32x4*)t = acc[ai][bj][m][0] * g0; *(f32x4*)(t + 4) = acc[ai][bj][m][1] * g1; } }
    }
};
struct EpiBranchB {
    static constexpr bool PERM = true, AFTER_DRAIN = false;
    const bf16_t* SG; int ldsg; const float* T1; bf16_t* MIX;
    __device__ __forceinline__ void operator()(const f32x4 (&acc)[2][2][4][2], const Unit& u, int wr, int wc, int fr, int fq) const {
        const int row0 = u.pm * BM + wr * 64 + fr, colb = u.pn * BM + wc * 32 + 8 * fq;
#pragma unroll
        for (int ai = 0; ai < 2; ++ai)
#pragma unroll
            for (int m = 0; m < 4; ++m) { const size_t row = (size_t)(row0 + ai * HALF + m * 16);
#pragma unroll
                for (int bj = 0; bj < 2; ++bj) { const int col = colb + bj * HALF; f32x4 g0, g1; unpack8(*(const u32x4*)(SG + row * ldsg + col), g0, g1);
                    const float* t = T1 + row * 2048 + col; const f32x4 a = *(const f32x4*)t + acc[ai][bj][m][0] * g0, b = *(const f32x4*)(t + 4) + acc[ai][bj][m][1] * g1;
                    *(u32x4*)(MIX + row * 2048 + col) = pack8(a, b); } }
    }
};
struct EpiF32 {
    static constexpr bool PERM = true, AFTER_DRAIN = false;
    float* Y; int ldc;
    __device__ __forceinline__ void operator()(const f32x4 (&acc)[2][2][4][2], const Unit& u, int wr, int wc, int fr, int fq) const {
        const int row0 = u.pm * BM + wr * 64 + fr, colb = u.pn * BM + wc * 32 + 8 * fq;
#pragma unroll
        for (int ai = 0; ai < 2; ++ai)
#pragma unroll
            for (int m = 0; m < 4; ++m) { const size_t row = (size_t)(row0 + ai * HALF + m * 16);
#pragma unroll
                for (int bj = 0; bj < 2; ++bj) { float* t = Y + row * ldc + colb + bj * HALF; *(f32x4*)t = acc[ai][bj][m][0]; *(f32x4*)(t + 4) = acc[ai][bj][m][1]; } }
    }
};
struct EpiSwiGLU {
    static constexpr bool PERM = true, AFTER_DRAIN = false;
    bf16_t* HID; int ldh;
    __device__ __forceinline__ void operator()(const f32x4 (&acc)[2][2][4][2], const Unit& u, int wr, int wc, int fr, int fq) const {
        const int row0 = u.pm * BM + wr * 64 + fr, col = u.pn * HALF + wc * 32 + 8 * fq;
#pragma unroll
        for (int ai = 0; ai < 2; ++ai)
#pragma unroll
            for (int m = 0; m < 4; ++m) { const size_t row = (size_t)(row0 + ai * HALF + m * 16);
                f32x4 a = acc[ai][0][m][0], b = acc[ai][0][m][1]; const f32x4 ua = acc[ai][1][m][0], ub = acc[ai][1][m][1];
#pragma unroll
                for (int e = 0; e < 4; ++e) { a[e] = a[e] * sigmoidf_(a[e]) * ua[e]; b[e] = b[e] * sigmoidf_(b[e]) * ub[e]; }
                *(u32x4*)(HID + row * ldh + col) = pack8(a, b); }
    }
};
template <class Epi, class Sched, bool ALIGN_EPI = false, bool SP2 = false>
__device__ __forceinline__ void gemm_phase(PG8_LAS unsigned char* lds, const Gemm g, const Sched& S, const Epi& E) {
    const int tid = threadIdx.x, wid = __builtin_amdgcn_readfirstlane(tid >> 6), lane = tid & 63, wr = wid >> 2, wc = wid & 3, fr = lane & 15, fq = lane >> 4;
    const int K = g.K, nt = K / BK;
    unsigned voffA[2], voffB[2];
#pragma unroll
    for (int i = 0; i < 2; ++i) { int R, C; stage_rc(tid * 16 + i * 8192, R, C); const int Rb = Epi::PERM ? ((R & ~31) + perm32(R & 31)) : R;
        voffA[i] = (unsigned)(R * K + C) * 2u; voffB[i] = (unsigned)(Rb * K + C) * 2u; }
    const size_t kstep = (size_t)(BK * 2);
    const size_t hstep = (size_t)HALF * K * 2;
    const size_t tstep = 2 * hstep;
    const unsigned ldsw = (unsigned)wid * 1024u;
    const int aoff = lds_byte(wr * 64 + fr, fq * 8), boff = lds_byte(wc * 32 + fr, fq * 8);
#define PG8_SA(b, h) (((b) * 2 + (h)) * HTB)
#define PG8_SB(b, h) ((4 + (b) * 2 + (h)) * HTB)
#define PG8_STAGE(bufoff, gbase, voff) do { _Pragma("unroll") for (int _i = 0; _i < 2; ++_i) \
        __builtin_amdgcn_global_load_lds((const unsigned*)((const char*)(gbase) + (voff)[_i]), (PG8_LAS unsigned*)(lds + (bufoff) + ldsw + _i * 8192), 16, 0, 0); } while (0)
#define PG8_LDA(dst, b, h) do { _Pragma("unroll") for (int m = 0; m < 4; ++m) _Pragma("unroll") for (int k = 0; k < 2; ++k) dst[m][k] = *(const PG8_LAS bf16x8*)(lds + PG8_SA(b, h) + aoff + m * 2048 + k * 1024); } while (0)
#define PG8_LDB(dst, b, h) do { _Pragma("unroll") for (int n = 0; n < 2; ++n) _Pragma("unroll") for (int k = 0; k < 2; ++k) dst[n][k] = *(const PG8_LAS bf16x8*)(lds + PG8_SB(b, h) + boff + n * 2048 + k * 1024); } while (0)
#define PG8_MMA(ai, bj, At, Bt) do { __builtin_amdgcn_s_setprio(1); _Pragma("unroll") for (int m = 0; m < 4; ++m) _Pragma("unroll") for (int n = 0; n < 2; ++n) _Pragma("unroll") for (int k = 0; k < 2; ++k) \
        acc[ai][bj][m][n] = __builtin_amdgcn_mfma_f32_16x16x32_bf16(Bt[n][k], At[m][k], acc[ai][bj][m][n], 0, 0, 0); __builtin_amdgcn_s_setprio(0); } while (0)
#define PG8_WAIT_V(n) asm volatile("s_waitcnt vmcnt(" #n ")" ::: "memory")
#define PG8_WAIT_L(n) asm volatile("s_waitcnt lgkmcnt(" #n ")" ::: "memory")
#define PG8_BAR __builtin_amdgcn_s_barrier()
#define PG8_SCHED __builtin_amdgcn_sched_barrier(0)
    Unit cur, nxt; int ui = 0;
    if (!S.next(0, cur)) return;
    f32x4 acc[2][2][4][2];
#pragma unroll
    for (int a = 0; a < 2; ++a)
#pragma unroll
        for (int b = 0; b < 2; ++b)
#pragma unroll
            for (int m = 0; m < 4; ++m)
#pragma unroll
                for (int n = 0; n < 2; ++n) acc[a][b][m][n] = (f32x4){0.f, 0.f, 0.f, 0.f};
    bf16x8 At[4][2], B0[2][2], B1[2][2];
    const char* cA = (const char*)g.A + (size_t)cur.pm * tstep; const char* cB = (const char*)g.Bt + (size_t)cur.pn * tstep;
    S.a_ready(cur);
    if constexpr (SP2) {
        PG8_STAGE(PG8_SB(0, 0), cB, voffB); PG8_STAGE(PG8_SB(0, 1), cB + hstep, voffB); PG8_STAGE(PG8_SA(0, 0), cA, voffA); PG8_STAGE(PG8_SA(0, 1), cA + hstep, voffA);
        if (wr == 1) PG8_BAR;
        PG8_WAIT_V(2); PG8_BAR;
        PG8_STAGE(PG8_SB(1, 0), cB + kstep, voffB); PG8_STAGE(PG8_SA(1, 0), cA + kstep, voffA); PG8_STAGE(PG8_SB(1, 1), cB + hstep + kstep, voffB);
        PG8_WAIT_V(6); PG8_BAR;
    } else {
        PG8_STAGE(PG8_SB(0, 0), cB, voffB); PG8_STAGE(PG8_SA(0, 0), cA, voffA); PG8_STAGE(PG8_SB(0, 1), cB + hstep, voffB); PG8_STAGE(PG8_SA(0, 1), cA + hstep, voffA);
        if (wr == 1) PG8_BAR;
        PG8_WAIT_V(4); PG8_BAR;
        PG8_STAGE(PG8_SB(1, 0), cB + kstep, voffB); PG8_STAGE(PG8_SA(1, 0), cA + kstep, voffA); PG8_STAGE(PG8_SB(1, 1), cB + hstep + kstep, voffB);
        PG8_WAIT_V(6); PG8_BAR;
    }
    for (;;) {
        const bool has_next = S.next(ui + 1, nxt);
        const char* nA = has_next ? (const char*)g.A + (size_t)nxt.pm * tstep : cA; const char* nB = has_next ? (const char*)g.Bt + (size_t)nxt.pn * tstep : cB;
        for (int t = 0; t < nt; t += 2) {
            const bool last = (t == nt - 2);
            const char* a1 = cA + (size_t)(t + 1) * kstep;
            const char* a2 = last ? nA : cA + (size_t)(t + 2) * kstep; const char* b2 = last ? nB : cB + (size_t)(t + 2) * kstep;
            const char* a3 = a2 + kstep; const char* b3 = b2 + kstep;
            if (last && has_next) S.a_ready(nxt);
            if constexpr (SP2) {
            PG8_LDB(B0, 0, 0); PG8_LDB(B1, 0, 1); PG8_SCHED; PG8_LDA(At, 0, 0); PG8_STAGE(PG8_SA(1, 1), a1 + hstep, voffA);
            PG8_WAIT_V(8); PG8_WAIT_L(0); PG8_BAR; PG8_MMA(0, 0, At, B0); PG8_MMA(0, 1, At, B1); PG8_BAR; PG8_SCHED;
            PG8_LDA(At, 0, 1); PG8_STAGE(PG8_SB(0, 0), b2, voffB); PG8_STAGE(PG8_SB(0, 1), b2 + hstep, voffB); PG8_STAGE(PG8_SA(0, 0), a2, voffA);
            PG8_WAIT_V(8); PG8_WAIT_L(0); PG8_BAR; PG8_MMA(1, 0, At, B0); PG8_MMA(1, 1, At, B1); PG8_BAR; PG8_SCHED;
            PG8_LDB(B0, 1, 0); PG8_LDB(B1, 1, 1); PG8_SCHED; PG8_LDA(At, 1, 0); PG8_STAGE(PG8_SA(0, 1), a2 + hstep, voffA);
            PG8_WAIT_V(8); PG8_WAIT_L(0); PG8_BAR; PG8_MMA(0, 0, At, B0); PG8_MMA(0, 1, At, B1); PG8_BAR; PG8_SCHED;
            PG8_LDA(At, 1, 1); PG8_STAGE(PG8_SB(1, 0), b3, voffB); PG8_STAGE(PG8_SB(1, 1), b3 + hstep, voffB); PG8_STAGE(PG8_SA(1, 0), a3, voffA);
            PG8_WAIT_V(8); PG8_WAIT_L(0); PG8_BAR; PG8_MMA(1, 0, At, B0); PG8_MMA(1, 1, At, B1); PG8_BAR; PG8_SCHED;
            } else {
            PG8_LDB(B0, 0, 0); PG8_SCHED; PG8_LDA(At, 0, 0); PG8_STAGE(PG8_SA(1, 1), a1 + hstep, voffA);
            PG8_WAIT_L(8); PG8_BAR; PG8_WAIT_L(0); PG8_MMA(0, 0, At, B0); PG8_BAR; PG8_SCHED;
            PG8_LDB(B1, 0, 1); PG8_STAGE(PG8_SB(0, 0), b2, voffB);
            PG8_BAR; PG8_WAIT_L(0); PG8_MMA(0, 1, At, B1); PG8_BAR;
            PG8_LDA(At, 0, 1); PG8_STAGE(PG8_SA(0, 0), a2, voffA);
            PG8_BAR; PG8_WAIT_L(0); PG8_MMA(1, 0, At, B0); PG8_BAR; PG8_SCHED;
            PG8_STAGE(PG8_SB(0, 1), b2 + hstep, voffB);
            PG8_WAIT_V(6); PG8_BAR; PG8_MMA(1, 1, At, B1); PG8_BAR;
            PG8_LDB(B0, 1, 0); PG8_SCHED; PG8_LDA(At, 1, 0); PG8_STAGE(PG8_SA(0, 1), a2 + hstep, voffA);
            PG8_WAIT_L(8); PG8_BAR; PG8_WAIT_L(0); PG8_MMA(0, 0, At, B0); PG8_BAR; PG8_SCHED;
            PG8_LDB(B1, 1, 1); PG8_STAGE(PG8_SB(1, 0), b3, voffB);
            PG8_BAR; PG8_WAIT_L(0); PG8_MMA(0, 1, At, B1); PG8_BAR;
            PG8_LDA(At, 1, 1); PG8_STAGE(PG8_SA(1, 0), a3, voffA);
            PG8_BAR; PG8_WAIT_L(0); PG8_MMA(1, 0, At, B0); PG8_BAR; PG8_SCHED;
            PG8_STAGE(PG8_SB(1, 1), b3 + hstep, voffB);
            PG8_WAIT_V(6); PG8_BAR; PG8_MMA(1, 1, At, B1); PG8_BAR;
            }
        }
        if constexpr (ALIGN_EPI) { if (wr == 0) PG8_BAR; }
        if constexpr (!Epi::AFTER_DRAIN) { E(acc, cur, wr, wc, fr, fq); S.done(cur); }
        if (!has_next) break;
#pragma unroll
        for (int a = 0; a < 2; ++a)
#pragma unroll
            for (int b = 0; b < 2; ++b)
#pragma unroll
                for (int m = 0; m < 4; ++m)
#pragma unroll
                    for (int n = 0; n < 2; ++n) acc[a][b][m][n] = (f32x4){0.f, 0.f, 0.f, 0.f};
        cur = nxt; cA = nA; cB = nB; ++ui;
        if constexpr (ALIGN_EPI) { if (wr == 1) PG8_BAR; }
    }
    PG8_WAIT_V(0);
    if constexpr (!ALIGN_EPI) { if (wr == 0) PG8_BAR; }
    PG8_BAR;
    if constexpr (Epi::AFTER_DRAIN) { E.fused(acc, cur, wr, wc, fr, fq, lds, wid, lane); S.done(cur); }
#undef PG8_SA
#undef PG8_SB
#undef PG8_STAGE
#undef PG8_LDA
#undef PG8_LDB
#undef PG8_MMA
#undef PG8_WAIT_V
#undef PG8_WAIT_L
#undef PG8_BAR
#undef PG8_SCHED
}
}
#define GAS __attribute__((address_space(1)))
#define LAS __attribute__((address_space(3)))
typedef unsigned short bf16;
typedef unsigned v4u __attribute__((ext_vector_type(4)));
typedef float f32x4 __attribute__((ext_vector_type(4)));
typedef short bf16x8 __attribute__((ext_vector_type(8)));
typedef GAS unsigned gu32;
typedef GAS unsigned long long gu64;
#define RLX_AGENT __ATOMIC_RELAXED, __HIP_MEMORY_SCOPE_AGENT
#define LDS_WAIT() asm volatile("s_waitcnt lgkmcnt(0)" ::: "memory")
#define VM_WAIT() asm volatile("s_waitcnt vmcnt(0)" ::: "memory")
__device__ __forceinline__ unsigned long long rt() { return __builtin_amdgcn_s_memrealtime(); }
__device__ __forceinline__ unsigned f2bf(float f) { unsigned u = __builtin_bit_cast(unsigned, f); return (u + 0x7fffu + ((u >> 16) & 1u)) >> 16; }
__device__ __forceinline__ unsigned pk2(float lo, float hi) { return f2bf(lo) | (f2bf(hi) << 16); }
#define XB_TMO      128
#define XB_XCNT(j)  (256  + 64 * (j))
#define XB_XSUB(j)  (1280 + 64 * (j))
#define XB_XGEN(j)  (2304 + 64 * (j))
#define XB_TOP      3328
#define XB_TOPGEN   3392
#define XCD_BAR_WORDS 3456
#define XB_SPIN_CAP (1u << 18)

__device__ __forceinline__ unsigned xb_ld(unsigned* p)              { return __hip_atomic_load(p, __ATOMIC_RELAXED, __HIP_MEMORY_SCOPE_AGENT); }
__device__ __forceinline__ unsigned xb_add(unsigned* p, unsigned v) { return __hip_atomic_fetch_add(p, v, __ATOMIC_RELAXED, __HIP_MEMORY_SCOPE_AGENT); }
__device__ __forceinline__ unsigned xb_xcc_id() { return (unsigned)__builtin_amdgcn_s_getreg((3 << 11) | 20) & 0xFu; }
#define XB_SPIN(cond, bar) do { unsigned _sp = 0; while (cond) { __builtin_amdgcn_s_sleep(1); \
    if ((++_sp & 255u) == 0u) { if (xb_ld(&(bar)[XB_TMO])) break; if (_sp > XB_SPIN_CAP) { atomicAdd(&(bar)[XB_TMO], 1u); break; } } } } while (0)

struct XcdBarrier {
    unsigned* bar; unsigned x;
    volatile LAS unsigned* st;
};

__device__ __forceinline__ XcdBarrier xcd_barrier_post(unsigned* bar, volatile LAS unsigned* st) {
    XcdBarrier b; b.bar = bar; b.x = xb_xcc_id(); b.st = st;
    if (threadIdx.x == 0) (void)xb_add(&bar[XB_XCNT(b.x)], 1u);
    return b;
}
__device__ __forceinline__ void xcd_barrier_complete(unsigned* bar, unsigned x, unsigned& nloc, unsigned& nx) {
    const unsigned G = gridDim.x * gridDim.y * gridDim.z;
    unsigned sum, cnt, mine, sp = 0u;
    for (;;) {
        sum = 0u; cnt = 0u; mine = 0u;
#pragma unroll
        for (unsigned j = 0; j < 16; ++j) { const unsigned c = xb_ld(&bar[XB_XCNT(j)]); sum += c; cnt += (c > 0u) ? 1u : 0u; mine = (j == x) ? c : mine; }
        if (sum == G) break;
        __builtin_amdgcn_s_sleep(1);
        if ((++sp & 255u) == 0u) { if (xb_ld(&bar[XB_TMO])) break; if (sp > XB_SPIN_CAP) { atomicAdd(&bar[XB_TMO], 1u); break; } }
    }
    nloc = mine > 0u ? mine : 1u; nx = cnt > 0u ? cnt : 1u;
}

__device__ __forceinline__ void xcd_barrier(const XcdBarrier& b) {
    asm volatile("s_waitcnt vmcnt(0)" ::: "memory");
    __syncthreads();
    if (threadIdx.x == 0) {
        unsigned* bar = b.bar;
        __builtin_amdgcn_s_waitcnt(0);
        unsigned nloc = b.st[0], nx = b.st[1];
        if (nloc == 0u) { xcd_barrier_complete(bar, b.x, nloc, nx); b.st[0] = nloc; b.st[1] = nx; }
        const unsigned old = xb_add(&bar[XB_XSUB(b.x)], 1u);
        const unsigned gen = old / nloc;
        if (old + 1u == (gen + 1u) * nloc) {
            __builtin_amdgcn_fence(__ATOMIC_RELEASE, "agent");
            asm volatile("s_waitcnt vmcnt(0)" ::: "memory");
            const unsigned og = xb_add(&bar[XB_TOP], 1u);
            const unsigned tg = og / nx;
            if (og + 1u == (tg + 1u) * nx) xb_add(&bar[XB_TOPGEN], 1u);
            else XB_SPIN(xb_ld(&bar[XB_TOPGEN]) == tg, bar);
            __builtin_amdgcn_fence(__ATOMIC_ACQUIRE, "agent");
            xb_add(&bar[XB_XGEN(b.x)], 1u);
            asm volatile("s_waitcnt vmcnt(0)" ::: "memory");
        } else {
            XB_SPIN(xb_ld(&bar[XB_XGEN(b.x)]) == gen, bar);
            __builtin_amdgcn_fence(__ATOMIC_ACQUIRE, "agent");
            asm volatile("s_waitcnt vmcnt(0)" ::: "memory");
        }
    }
    __syncthreads();
}
constexpr int NWAVES = 8;
constexpr int DM = 2048, PB = 4, PL = 2048, MP = PB * PL, SB = 8, SL = 8, MS = SB * SL, MREAL = MP + MS, MT = 8448;
constexpr int NIN = 11264, DFF = 5632, NH = 8, HDK = 128, HDV = 128, DAH = 8, DADH = 64, DADV = 128;
constexpr int PAST = 16384, PAGE = 128, NPAGES = PAST / PAGE, NPOOL = 1280;
constexpr int C_HQ = 0, C_HF = 1024, C_HI = 2048, C_HGATE = 3072, C_DQ = 4096, C_DK = 5120, C_DV = 6144, C_GHG = 7168, C_GDA = 9216;
constexpr float RMS_EPS = 1e-6f, LOG2E = 1.4426950408889634f;
constexpr float QSCALE = 0.125f * LOG2E;
constexpr float LAM_INIT = 0.2f;
constexpr size_t O_YP = 0, O_YS = O_YP + (size_t)MP * DM, O_KP = O_YS + (size_t)MS * DM, O_VP = O_KP + (size_t)MP * 1024, O_SP = O_VP + (size_t)MP * 1024,
                 O_KS = O_SP + (size_t)PB * NH * HDK * HDV, O_VS = O_KS + (size_t)MS * 1024, O_SS = O_VS + (size_t)MS * 1024, O_END = O_SS + (size_t)SB * NH * HDK * HDV;
constexpr size_t MiB = 1u << 20;
constexpr size_t WS_CTL = 0, CTL_ZERO_BYTES = 1 * MiB;
constexpr size_t WS_WIN = 2 * MiB, WS_WBH = 48 * MiB, WS_WBD = 54 * MiB, WS_WOUT = 60 * MiB, WS_WUP = 70 * MiB, WS_WDN = 116 * MiB;
constexpr size_t WS_XN = 140 * MiB, WS_U = 176 * MiB, WS_G = 360 * MiB, WS_OHG = 396 * MiB, WS_ODA = 414 * MiB, WS_T1 = 432 * MiB, WS_MIX = 500 * MiB,
                 WS_Y1 = 536 * MiB, WS_X1 = 604 * MiB, WS_XN2 = 672 * MiB, WS_HID = 708 * MiB, WS_Y2 = 800 * MiB, WS_DEC = 868 * MiB, WS_END = 900 * MiB;
static_assert(WS_WIN + (size_t)NIN * DM * 2 <= WS_WBH && WS_WUP + (size_t)NIN * DM * 2 <= WS_WDN && WS_WDN + (size_t)DM * DFF * 2 <= WS_XN && WS_XN + (size_t)MT * DM * 2 <= WS_U &&
              WS_U + (size_t)MT * NIN * 2 <= WS_G && WS_G + (size_t)MT * 1024 * 4 <= WS_OHG && WS_OHG + (size_t)MT * 1024 * 2 <= WS_ODA && WS_ODA + (size_t)MT * 1024 * 2 <= WS_T1 &&
              WS_T1 + (size_t)MT * DM * 4 <= WS_MIX && WS_MIX + (size_t)MT * DM * 2 <= WS_Y1 && WS_Y1 + (size_t)MT * DM * 4 <= WS_X1 && WS_X1 + (size_t)MT * DM * 4 <= WS_XN2 &&
              WS_XN2 + (size_t)MT * DM * 2 <= WS_HID && WS_HID + (size_t)MT * DFF * 2 <= WS_Y2 && WS_Y2 + (size_t)MT * DM * 4 <= WS_DEC, "d_ws map");
constexpr int CW_TMO = 0, CW_CODE = 1, CW_BAR = 4096;
constexpr int RING_OFF = 0, RING_BYTES = 131072;
constexpr int LDSCTL_OFF = RING_BYTES, MISC_OFF = LDSCTL_OFF + 320;
constexpr int LDS_BYTES = 147456;
static_assert(MISC_OFF + 128 <= LDS_BYTES, "LDS map");
struct Args { const float* in[24]; const int* page_table; float* out; unsigned char* ws; int ph_lo, ph_hi; };
struct Frame {
    LAS unsigned char* lds; volatile LAS unsigned* MISC; gu32* ctl;
    int tid, lane, wave, vcu, G;
};
__device__ __forceinline__ float wave_sum(float v) {
#pragma unroll
    for (int o = 1; o < 64; o <<= 1) v += __shfl_xor(v, o);
    return v;
}
__device__ __forceinline__ float bf2f(bf16 h) { return __uint_as_float((unsigned)h << 16); }
__device__ __forceinline__ int t5_bucket(int n) {
    if (n < 16) return n;
    if (n >= 113) return 31;
    int b = 16;
    b += (n >= 19); b += (n >= 21); b += (n >= 24); b += (n >= 27); b += (n >= 31); b += (n >= 35); b += (n >= 40); b += (n >= 46);
    b += (n >= 52); b += (n >= 59); b += (n >= 67); b += (n >= 77); b += (n >= 87); b += (n >= 99);
    return b;
}
__device__ __forceinline__ void p0_transpose_item(const float* W, int K, int N, bf16* WT, int k0, int n0, int dst_row0, LAS float* scr, int lane) {
#pragma unroll 8
    for (int i = 0; i < 32; ++i) { const int kk = 2 * i + (lane >> 5); scr[kk * 33 + (lane & 31)] = W[(size_t)(k0 + kk) * N + n0 + (lane & 31)]; }
    LDS_WAIT(); asm volatile("" ::: "memory");
    const int c = lane & 7;
#pragma unroll
    for (int j = 0; j < 4; ++j) { const int n = (lane >> 3) + 8 * j; const LAS float* s = scr + (8 * c) * 33 + n;
        v4u o; o.x = pk2(s[0 * 33], s[1 * 33]); o.y = pk2(s[2 * 33], s[3 * 33]); o.z = pk2(s[4 * 33], s[5 * 33]); o.w = pk2(s[6 * 33], s[7 * 33]);
        *(GAS v4u*)(WT + (size_t)(dst_row0 + n) * K + k0 + 8 * c) = o; }
    LDS_WAIT(); asm volatile("" ::: "memory");
}
__device__ __forceinline__ void rms_row_to_bf16(const float* xrow, const float* w, bf16* orow, int lane) {
    GAS unsigned long long* o8 = (GAS unsigned long long*)orow + lane;
    if (!xrow) {
#pragma unroll
        for (int j = 0; j < 8; ++j) o8[64 * j] = 0ull;
        return; }
    const GAS f32x4* xr = (const GAS f32x4*)xrow + lane; const GAS f32x4* wr = (const GAS f32x4*)w + lane;
    f32x4 v[8]; float s = 0.f;
#pragma unroll
    for (int j = 0; j < 8; ++j) { v[j] = xr[64 * j]; s += (v[j].x * v[j].x + v[j].y * v[j].y) + (v[j].z * v[j].z + v[j].w * v[j].w); }
    const float rstd = 1.0f / sqrtf(wave_sum(s) * (1.0f / DM) + RMS_EPS);
#pragma unroll
    for (int j = 0; j < 8; ++j) { const f32x4 g = wr[64 * j]; o8[64 * j] = (unsigned long long)pk2(v[j].x * rstd * g.x, v[j].y * rstd * g.y) | ((unsigned long long)pk2(v[j].z * rstd * g.z, v[j].w * rstd * g.w) << 32); }
}
__device__ __forceinline__ const float* x_row(const Args& a, int m) { return m < MP ? a.in[0] + (size_t)m * DM : (m < MREAL ? a.in[1] + (size_t)(m - MP) * DM : nullptr); }

__device__ __forceinline__ void p0_prologue(Frame& F, const Args& a) {
    unsigned char* ws = a.ws;
    LAS float* scr = (LAS float*)(F.lds + RING_OFF + F.wave * 16384);
    const int gw = F.vcu * NWAVES + F.wave, NGW = F.G * NWAVES;
    constexpr int I_IN = (DM / 64) * (NIN / 32), I_BH = (1024 / 64) * (DM / 32), I_OUT = (DM / 64) * (DM / 32), I_UP = I_IN, I_DN = (DFF / 64) * (DM / 32);
    constexpr int NITEMS = I_IN + 2 * I_BH + I_OUT + I_UP + I_DN;
    for (int it = gw; it < NITEMS; it += NGW) {
        int r = it;
        if (r < I_IN) { const int nb = NIN / 32, kb = r / nb, n0 = 32 * (r % nb); p0_transpose_item(a.in[10], DM, NIN, (bf16*)(ws + WS_WIN), 64 * kb, n0, n0, scr, F.lane); continue; } r -= I_IN;
        if (r < I_BH) { const int nb = DM / 32, kb = r / nb, n0 = 32 * (r % nb); p0_transpose_item(a.in[19], 1024, DM, (bf16*)(ws + WS_WBH), 64 * kb, n0, n0, scr, F.lane); continue; } r -= I_BH;
        if (r < I_BH) { const int nb = DM / 32, kb = r / nb, n0 = 32 * (r % nb); p0_transpose_item(a.in[20], 1024, DM, (bf16*)(ws + WS_WBD), 64 * kb, n0, n0, scr, F.lane); continue; } r -= I_BH;
        if (r < I_OUT) { const int nb = DM / 32, kb = r / nb, n0 = 32 * (r % nb); p0_transpose_item(a.in[21], DM, DM, (bf16*)(ws + WS_WOUT), 64 * kb, n0, n0, scr, F.lane); continue; } r -= I_OUT;
        if (r < I_UP) { const int nb = NIN / 32, kb = r / nb, n0 = 32 * (r % nb);
            const int isup = n0 >= DFF, nn = isup ? n0 - DFF : n0, dst = 256 * (nn / 128) + (isup ? 128 : 0) + (nn % 128);
            p0_transpose_item(a.in[22], DM, NIN, (bf16*)(ws + WS_WUP), 64 * kb, n0, dst, scr, F.lane); continue; } r -= I_UP;
        { const int nb = DM / 32, kb = r / nb, n0 = 32 * (r % nb); p0_transpose_item(a.in[23], DFF, DM, (bf16*)(ws + WS_WDN), 64 * kb, n0, n0, scr, F.lane); }
    }
    for (int m = gw; m < MT; m += NGW) rms_row_to_bf16(x_row(a, m), a.in[6], (bf16*)(ws + WS_XN) + (size_t)m * DM, F.lane);
    for (int m = MREAL + gw; m < MT; m += NGW) { GAS unsigned long long* p = (GAS unsigned long long*)((bf16*)(ws + WS_OHG) + (size_t)m * 1024) + F.lane; GAS unsigned long long* q = (GAS unsigned long long*)((bf16*)(ws + WS_ODA) + (size_t)m * 1024) + F.lane;
#pragma unroll
        for (int j = 0; j < 4; ++j) { p[64 * j] = 0ull; q[64 * j] = 0ull; } }
}
__device__ __forceinline__ void row_pass1(Frame& F, const Args& a) {
    unsigned char* ws = a.ws; const int gw = F.vcu * NWAVES + F.wave, NGW = F.G * NWAVES;
    for (int m = gw; m < MT; m += NGW) {
        bf16* orow = (bf16*)(ws + WS_XN2) + (size_t)m * DM; GAS unsigned long long* o8 = (GAS unsigned long long*)orow + F.lane;
        const float* xrow = x_row(a, m);
        if (!xrow) {
#pragma unroll
            for (int j = 0; j < 8; ++j) o8[64 * j] = 0ull;
            continue; }
        const GAS f32x4* yr = (const GAS f32x4*)((const float*)(ws + WS_Y1) + (size_t)m * DM) + F.lane; const GAS f32x4* xr = (const GAS f32x4*)xrow + F.lane;
        const GAS f32x4* w1 = (const GAS f32x4*)a.in[7] + F.lane; const GAS f32x4* w2 = (const GAS f32x4*)a.in[8] + F.lane; GAS f32x4* x1o = (GAS f32x4*)((float*)(ws + WS_X1) + (size_t)m * DM) + F.lane;
        f32x4 v[8]; float s = 0.f;
#pragma unroll
        for (int j = 0; j < 8; ++j) { v[j] = yr[64 * j]; s += (v[j].x * v[j].x + v[j].y * v[j].y) + (v[j].z * v[j].z + v[j].w * v[j].w); }
        const float rstd = 1.0f / sqrtf(wave_sum(s) * (1.0f / DM) + RMS_EPS); float s2 = 0.f;
#pragma unroll
        for (int j = 0; j < 8; ++j) { v[j] = xr[64 * j] + v[j] * rstd * w1[64 * j]; x1o[64 * j] = v[j]; s2 += (v[j].x * v[j].x + v[j].y * v[j].y) + (v[j].z * v[j].z + v[j].w * v[j].w); }
        const float rstd2 = 1.0f / sqrtf(wave_sum(s2) * (1.0f / DM) + RMS_EPS);
#pragma unroll
        for (int j = 0; j < 8; ++j) { const f32x4 g = w2[64 * j]; o8[64 * j] = (unsigned long long)pk2(v[j].x * rstd2 * g.x, v[j].y * rstd2 * g.y) | ((unsigned long long)pk2(v[j].z * rstd2 * g.z, v[j].w * rstd2 * g.w) << 32); }
    }
}
__device__ __forceinline__ void row_pass2(Frame& F, const Args& a) {
    unsigned char* ws = a.ws; const int gw = F.vcu * NWAVES + F.wave, NGW = F.G * NWAVES;
    for (int m = gw; m < MREAL; m += NGW) {
        const GAS f32x4* yr = (const GAS f32x4*)((const float*)(ws + WS_Y2) + (size_t)m * DM) + F.lane; const GAS f32x4* xr = (const GAS f32x4*)((const float*)(ws + WS_X1) + (size_t)m * DM) + F.lane;
        const GAS f32x4* w1 = (const GAS f32x4*)a.in[9] + F.lane;
        GAS f32x4* o = (GAS f32x4*)(m < MP ? a.out + O_YP + (size_t)m * DM : a.out + O_YS + (size_t)(m - MP) * DM) + F.lane;
        f32x4 v[8]; float s = 0.f;
#pragma unroll
        for (int j = 0; j < 8; ++j) { v[j] = yr[64 * j]; s += (v[j].x * v[j].x + v[j].y * v[j].y) + (v[j].z * v[j].z + v[j].w * v[j].w); }
        const float rstd = 1.0f / sqrtf(wave_sum(s) * (1.0f / DM) + RMS_EPS);
#pragma unroll
        for (int j = 0; j < 8; ++j) o[64 * j] = xr[64 * j] + v[j] * rstd * w1[64 * j];
    }
}

constexpr int N_PHASES = 9;
__global__ void __launch_bounds__(NWAVES * 64, 2) mk_fwd(Args args) {
    extern __shared__ __attribute__((aligned(16))) unsigned char lds[];
    Frame F;
    F.lds = (LAS unsigned char*)lds; F.MISC = (volatile LAS unsigned*)(F.lds + MISC_OFF);
    F.tid = threadIdx.x; F.lane = F.tid & 63; F.wave = __builtin_amdgcn_readfirstlane(F.tid >> 6);
    F.G = gridDim.x; { const int bx = blockIdx.x; F.vcu = (F.G % 8 == 0) ? (bx % 8) * (F.G / 8) + bx / 8 : bx; }
    unsigned char* ws = args.ws;
    F.ctl = (gu32*)(ws + WS_CTL);
    for (int u = F.tid; u < (LDS_BYTES - LDSCTL_OFF) / 4; u += NWAVES * 64) ((LAS unsigned*)(F.lds + LDSCTL_OFF))[u] = 0u;
    __syncthreads();
    const int lo = args.ph_lo, hi = args.ph_hi;
    XcdBarrier bar = xcd_barrier_post((unsigned*)(F.ctl + CW_BAR) + lo * XCD_BAR_WORDS, F.MISC + 8);
#define IN(k) (lo <= (k) && (k) < hi)
#define BOTH(k) (IN(k) && IN((k) + 1))
#define GRID_BAR() xcd_barrier(bar)
    if (IN(0)) { p0_prologue(F, args); if (BOTH(0)) GRID_BAR(); }
    if (IN(1)) {
        pg8::Gemm g{(const bf16*)(ws + WS_XN), (const bf16*)(ws + WS_WIN), MT, NIN, DM}; pg8::StaticOrder S; S.init(MT, NIN, F.G, (int)blockIdx.x);
        pg8::EpiInProj E{(bf16*)(ws + WS_U), (float*)(ws + WS_G), args.out + O_KP, args.out + O_VP, args.out + O_KS, args.out + O_VS, args.in[11], NIN, MP, MREAL, QSCALE};
        pg8::gemm_phase<pg8::EpiInProj, pg8::StaticOrder, true, true>(F.lds + RING_OFF, g, S, E);
        if (BOTH(1)) GRID_BAR();
    }
    if (IN(2)) { if (BOTH(2)) GRID_BAR(); }
    if (IN(3)) {
        { pg8::Gemm g{(const bf16*)(ws + WS_OHG), (const bf16*)(ws + WS_WBH), MT, DM, 1024}; pg8::StaticOrder S; S.init(MT, DM, F.G, (int)blockIdx.x);
          pg8::EpiBranchA E{(const bf16*)(ws + WS_U) + C_GHG, NIN, (float*)(ws + WS_T1)};
          pg8::gemm_phase<pg8::EpiBranchA, pg8::StaticOrder, true, true>(F.lds + RING_OFF, g, S, E); }
        { pg8::Gemm g{(const bf16*)(ws + WS_ODA), (const bf16*)(ws + WS_WBD), MT, DM, 1024}; pg8::StaticOrder S; S.init(MT, DM, F.G, (int)blockIdx.x);
          pg8::EpiBranchB E{(const bf16*)(ws + WS_U) + C_GDA, NIN, (const float*)(ws + WS_T1), (bf16*)(ws + WS_MIX)};
          pg8::gemm_phase<pg8::EpiBranchB, pg8::StaticOrder, true, true>(F.lds + RING_OFF, g, S, E); }
        if (BOTH(3)) GRID_BAR();
    }
    if (IN(4)) {
        pg8::Gemm g{(const bf16*)(ws + WS_MIX), (const bf16*)(ws + WS_WOUT), MT, DM, DM}; pg8::StaticOrder S; S.init(MT, DM, F.G, (int)blockIdx.x);
        pg8::EpiF32 E{(float*)(ws + WS_Y1), DM};
        pg8::gemm_phase<pg8::EpiF32, pg8::StaticOrder, true, true>(F.lds + RING_OFF, g, S, E);
        if (BOTH(4)) GRID_BAR();
    }
    if (IN(5)) { row_pass1(F, args); if (BOTH(5)) GRID_BAR(); }
    if (IN(6)) {
        pg8::Gemm g{(const bf16*)(ws + WS_XN2), (const bf16*)(ws + WS_WUP), MT, NIN, DM}; pg8::StaticOrder S; S.init(MT, NIN, F.G, (int)blockIdx.x);
        pg8::EpiSwiGLU E{(bf16*)(ws + WS_HID), DFF};
        pg8::gemm_phase<pg8::EpiSwiGLU, pg8::StaticOrder, true, true>(F.lds + RING_OFF, g, S, E);
        if (BOTH(6)) GRID_BAR();
    }
    if (IN(7)) {
        pg8::Gemm g{(const bf16*)(ws + WS_HID), (const bf16*)(ws + WS_WDN), MT, DM, DFF}; pg8::StaticOrder S; S.init(MT, DM, F.G, (int)blockIdx.x);
        pg8::EpiF32 E{(float*)(ws + WS_Y2), DM};
        pg8::gemm_phase<pg8::EpiF32, pg8::StaticOrder, true, true>(F.lds + RING_OFF, g, S, E);
        if (BOTH(7)) GRID_BAR();
    }
    if (IN(8)) { row_pass2(F, args); }
#undef IN
#undef BOTH
#undef GRID_BAR
}
__device__ __forceinline__ float da_lambda(const Args& a) {
    float s1 = 0.f, s2 = 0.f;
    for (int i = 0; i < DADH; ++i) { s1 += a.in[13][i] * a.in[14][i]; s2 += a.in[15][i] * a.in[16][i]; }
    return expf(s1) - expf(s2) + LAM_INIT;
}
__global__ void __launch_bounds__(512) hgrn_naive(Args a) {
    __shared__ float red[4][128]; __shared__ float red2[2];
    const int tid = threadIdx.x, v = tid & 127, dg = tid >> 7, lane = tid & 63, wave = tid >> 6;
    const bf16* U = (const bf16*)(a.ws + WS_U); const float* G = (const float*)(a.ws + WS_G); bf16* OHG = (bf16*)(a.ws + WS_OHG);
    int bx = blockIdx.x, h, row0, L; const float* S0; float* Sout;
    if (bx < PB * NH) { const int b = bx / NH; h = bx % NH; row0 = b * PL; L = PL; S0 = nullptr; Sout = a.out + O_SP + (size_t)bx * HDK * HDV; }
    else { bx -= PB * NH; const int s = bx / NH; h = bx % NH; row0 = MP + s * SL; L = SL; S0 = a.in[4] + (size_t)bx * HDK * HDV; Sout = a.out + O_SS + (size_t)bx * HDK * HDV; }
    float S[32];
#pragma unroll
    for (int i = 0; i < 32; ++i) S[i] = S0 ? S0[(size_t)(dg * 32 + i) * HDV + v] : 0.f;
    const float nw = a.in[12][v];
    for (int t = 0; t < L; ++t) {
        const size_t row = (size_t)(row0 + t);
        const float* gr = G + row * 1024 + h * HDK + dg * 32; const bf16* qr = U + row * NIN + C_HQ + h * HDK + dg * 32;
        const float iv = bf2f(U[row * NIN + C_HI + h * HDV + v]);
        float part = 0.f;
#pragma unroll
        for (int i = 0; i < 32; ++i) { const float f = expf(gr[i]), q = bf2f(qr[i]); S[i] = f * S[i] + (1.0f - f) * iv; part += S[i] * q; }
        red[dg][v] = part; __syncthreads();
        const float o = (red[0][v] + red[1][v]) + (red[2][v] + red[3][v]);
        if (dg == 0) { const float ss = wave_sum(o * o); if (lane == 0) red2[wave] = ss; }
        __syncthreads();
        if (dg == 0) { const float rstd = 1.0f / sqrtf((red2[0] + red2[1]) * (1.0f / HDV) + RMS_EPS);
            const float gate = bf2f(U[row * NIN + C_HGATE + h * HDV + v]);
            OHG[row * 1024 + h * HDV + v] = (bf16)f2bf(o * rstd * nw * gate); }
        __syncthreads();
    }
#pragma unroll
    for (int i = 0; i < 32; ++i) Sout[(size_t)(dg * 32 + i) * HDV + v] = S[i];
}
__global__ void __launch_bounds__(256) attn_prompt_naive(Args a) {
    __shared__ float q1[64], q2[64], sc1[PL], sc2[PL], redf[8], pv[128];
    const int tid = threadIdx.x, lane = tid & 63, wave = tid >> 6;
    const int row = blockIdx.x, h = blockIdx.y, b = row / PL, i = row % PL;
    const bf16* U = (const bf16*)(a.ws + WS_U); bf16* ODA = (bf16*)(a.ws + WS_ODA);
    const float lam = da_lambda(a);
    if (tid < 64) q1[tid] = bf2f(U[(size_t)row * NIN + C_DQ + h * 64 + tid]); else if (tid < 128) q2[tid - 64] = bf2f(U[(size_t)row * NIN + C_DQ + (8 + h) * 64 + tid - 64]);
    __syncthreads();
    const float* tab = a.in[18];
    float m1 = -1e30f, m2 = -1e30f;
    for (int j = tid; j <= i; j += 256) {
        const bf16* k1 = U + (size_t)(b * PL + j) * NIN + C_DK + h * 64; const bf16* k2 = k1 + 8 * 64;
        float s1 = 0.f, s2 = 0.f;
        for (int d = 0; d < 64; ++d) { s1 += q1[d] * bf2f(k1[d]); s2 += q2[d] * bf2f(k2[d]); }
        const int bk = t5_bucket(i - j);
        s1 += tab[bk * 16 + h] * LOG2E; s2 += tab[bk * 16 + 8 + h] * LOG2E;
        sc1[j] = s1; sc2[j] = s2; m1 = fmaxf(m1, s1); m2 = fmaxf(m2, s2);
    }
#pragma unroll
    for (int o = 1; o < 64; o <<= 1) { m1 = fmaxf(m1, __shfl_xor(m1, o)); m2 = fmaxf(m2, __shfl_xor(m2, o)); }
    if (lane == 0) { redf[wave] = m1; redf[4 + wave] = m2; }
    __syncthreads();
    m1 = fmaxf(fmaxf(redf[0], redf[1]), fmaxf(redf[2], redf[3])); m2 = fmaxf(fmaxf(redf[4], redf[5]), fmaxf(redf[6], redf[7]));
    __syncthreads();
    float l1 = 0.f, l2 = 0.f;
    for (int j = tid; j <= i; j += 256) { const float p1 = exp2f(sc1[j] - m1), p2 = exp2f(sc2[j] - m2); sc1[j] = p1; sc2[j] = p2; l1 += p1; l2 += p2; }
    l1 = wave_sum(l1); l2 = wave_sum(l2);
    if (lane == 0) { redf[wave] = l1; redf[4 + wave] = l2; }
    __syncthreads();
    l1 = (redf[0] + redf[1]) + (redf[2] + redf[3]); l2 = (redf[4] + redf[5]) + (redf[6] + redf[7]);
    const float r1 = 1.0f / l1, r2 = lam / l2;
    for (int j = tid; j <= i; j += 256) sc1[j] = sc1[j] * r1 - sc2[j] * r2;
    __syncthreads();
    const int v = tid & 127, half = tid >> 7;
    float acc = 0.f;
    for (int j = half; j <= i; j += 2) acc += sc1[j] * bf2f(U[(size_t)(b * PL + j) * NIN + C_DV + h * 128 + v]);
    if (half == 1) pv[v] = acc;
    __syncthreads();
    if (half == 0) { acc += pv[v]; const float ss = wave_sum(acc * acc); if (lane == 0) redf[wave] = ss; }
    __syncthreads();
    if (half == 0) { const float rstd = 1.0f / sqrtf((redf[0] + redf[1]) * (1.0f / 128) + RMS_EPS);
        ODA[(size_t)row * 1024 + h * 128 + v] = (bf16)f2bf(acc * rstd * a.in[17][v] * (1.0f - LAM_INIT)); }
}
__device__ __forceinline__ const float* dec_k(const Args& a, int s, int kk, int mh) {
    if (kk < PAST) { const int pg = a.page_table[s * NPAGES + (kk >> 7)]; return a.in[2] + ((size_t)pg * PAGE + (kk & 127)) * 1024 + mh * 64; }
    return a.out + O_KS + (size_t)(s * SL + kk - PAST) * 1024 + mh * 64;
}
__device__ __forceinline__ const float* dec_v(const Args& a, int s, int kk, int h) {
    if (kk < PAST) { const int pg = a.page_table[s * NPAGES + (kk >> 7)]; return a.in[3] + ((size_t)pg * PAGE + (kk & 127)) * 1024 + h * 128; }
    return a.out + O_VS + (size_t)(s * SL + kk - PAST) * 1024 + h * 128;
}
__global__ void __launch_bounds__(256) attn_decode_naive(Args a) {
    __shared__ float mlm[16][16], mll[16][16], M[16], Lr[16], P[16][64], osum[8][128];
    const int tid = threadIdx.x, lane = tid & 63, wave = tid >> 6;
    const int s = blockIdx.x / NH, h = blockIdx.x % NH;
    const bf16* U = (const bf16*)(a.ws + WS_U); bf16* ODA = (bf16*)(a.ws + WS_ODA);
    const float lam = da_lambda(a); const float* tab = a.in[18];
    const int c = tid & 15, ks = tid >> 4, mp = c >> 3, j = c & 7;
    float qr[64];
    { const bf16* qp = U + (size_t)(MP + s * SL + j) * NIN + C_DQ + (mp * 8 + h) * 64;
#pragma unroll
      for (int d = 0; d < 64; ++d) qr[d] = bf2f(qp[d]); }
    const int NK = PAST + SL;
    float m = -1e30f, l = 0.f;
    for (int kk = ks; kk < NK; kk += 16) {
        const int dist = PAST + j - kk; if (dist < 0) continue;
        const float* kp = dec_k(a, s, kk, mp * 8 + h); float sc = 0.f;
#pragma unroll
        for (int d = 0; d < 64; d += 4) { const f32x4 t = *(const f32x4*)(kp + d); sc += qr[d] * t.x + qr[d + 1] * t.y + qr[d + 2] * t.z + qr[d + 3] * t.w; }
        sc += tab[t5_bucket(dist) * 16 + mp * 8 + h] * LOG2E;
        const float mn = fmaxf(m, sc); l = l * exp2f(m - mn) + exp2f(sc - mn); m = mn;
    }
    mlm[c][ks] = m; mll[c][ks] = l;
    __syncthreads();
    if (tid < 16) { float mm = -1e30f; for (int w = 0; w < 16; ++w) mm = fmaxf(mm, mlm[tid][w]); float ll = 0.f; for (int w = 0; w < 16; ++w) ll += mll[tid][w] * exp2f(mlm[tid][w] - mm); M[tid] = mm; Lr[tid] = 1.0f / ll; }
    __syncthreads();
    const float Mc = M[c], Lc = Lr[c] * (mp ? -lam : 1.0f);
    const int v = tid & 127, jh = tid >> 7;
    float o0 = 0.f, o1 = 0.f, o2 = 0.f, o3 = 0.f;
    for (int k0 = 0; k0 < NK; k0 += 64) {
        for (int r = 0; r < 4; ++r) { const int kq = ks + 16 * r, kk = k0 + kq; float p = 0.f; const int dist = PAST + j - kk;
            if (kk < NK && dist >= 0) { const float* kp = dec_k(a, s, kk, mp * 8 + h); float sc = 0.f;
#pragma unroll
                for (int d = 0; d < 64; d += 4) { const f32x4 t = *(const f32x4*)(kp + d); sc += qr[d] * t.x + qr[d + 1] * t.y + qr[d + 2] * t.z + qr[d + 3] * t.w; }
                sc += tab[t5_bucket(dist) * 16 + mp * 8 + h] * LOG2E; p = exp2f(sc - Mc) * Lc; }
            P[c][kq] = p; }
        __syncthreads();
        const int kend = (NK - k0) < 64 ? (NK - k0) : 64;
        for (int kq = 0; kq < kend; ++kq) { const float vv = dec_v(a, s, k0 + kq, h)[v];
            o0 += (P[4 * jh + 0][kq] + P[8 + 4 * jh + 0][kq]) * vv; o1 += (P[4 * jh + 1][kq] + P[8 + 4 * jh + 1][kq]) * vv;
            o2 += (P[4 * jh + 2][kq] + P[8 + 4 * jh + 2][kq]) * vv; o3 += (P[4 * jh + 3][kq] + P[8 + 4 * jh + 3][kq]) * vv; }
        __syncthreads();
    }
    osum[4 * jh + 0][v] = o0; osum[4 * jh + 1][v] = o1; osum[4 * jh + 2][v] = o2; osum[4 * jh + 3][v] = o3;
    __syncthreads();
    for (int r = 0; r < 2; ++r) { const int jr = 2 * wave + r; const float x0 = osum[jr][lane], x1 = osum[jr][64 + lane];
        const float rstd = 1.0f / sqrtf(wave_sum(x0 * x0 + x1 * x1) * (1.0f / 128) + RMS_EPS);
        bf16* op = ODA + (size_t)(MP + s * SL + jr) * 1024 + h * 128;
        op[lane] = (bf16)f2bf(x0 * rstd * a.in[17][lane] * (1.0f - LAM_INIT)); op[64 + lane] = (bf16)f2bf(x1 * rstd * a.in[17][64 + lane] * (1.0f - LAM_INIT)); }
}

extern "C" void kernel_launch(void* const* d_in, const int* in_sizes, int n_in, void* d_out, int out_size, void* d_ws, size_t ws_size, hipStream_t stream) {
    static int grid = 0;
    if (grid == 0) {
        if (n_in != 24 || in_sizes[0] != MP * DM || (size_t)out_size != O_END || ws_size < WS_END) { fprintf(stderr, "kernel_launch: unexpected shapes (n_in %d, in0 %d, out %d, ws %zu); nothing launched\n", n_in, n_in > 0 ? in_sizes[0] : -1, out_size, ws_size); grid = -1; return; }
        int dev = 0, cus = 0, per_cu = 0;
        if (hipGetDevice(&dev) != hipSuccess || hipDeviceGetAttribute(&cus, hipDeviceAttributeMultiprocessorCount, dev) != hipSuccess) { grid = -1; return; }
        if (hipFuncSetAttribute((const void*)mk_fwd, hipFuncAttributeMaxDynamicSharedMemorySize, LDS_BYTES) != hipSuccess) { fprintf(stderr, "kernel_launch: hipFuncSetAttribute failed\n"); grid = -1; return; }
        if (hipOccupancyMaxActiveBlocksPerMultiprocessor(&per_cu, (const void*)mk_fwd, NWAVES * 64, LDS_BYTES) != hipSuccess || per_cu < 1) fprintf(stderr, "kernel_launch: note: occupancy query reports %d\n", per_cu);
        (void)hipGetLastError();
        grid = cus;
    }
    if (grid < 0) return;
    (void)hipMemsetAsync((char*)d_ws + WS_CTL, 0, CTL_ZERO_BYTES, stream);
    Args a{};
    for (int i = 0; i < 24; ++i) a.in[i] = (const float*)d_in[i];
    a.page_table = (const int*)d_in[5]; a.out = (float*)d_out; a.ws = (unsigned char*)d_ws;
    a.ph_lo = 0; a.ph_hi = 2;
    hipLaunchKernelGGL(mk_fwd, dim3(grid), dim3(NWAVES * 64), LDS_BYTES, stream, a);
    hipLaunchKernelGGL(hgrn_naive, dim3(PB * NH + SB * NH), dim3(512), 0, stream, a);
    hipLaunchKernelGGL(attn_prompt_naive, dim3(MP, NH), dim3(256), 0, stream, a);
    hipLaunchKernelGGL(attn_decode_naive, dim3(SB * NH), dim3(256), 0, stream, a);
    a.ph_lo = 3; a.ph_hi = 9;
    hipLaunchKernelGGL(mk_fwd, dim3(grid), dim3(NWAVES * 64), LDS_BYTES, stream, a);
}
```

```cpp
#include <hip/hip_runtime.h>
#include <cstdio>
#include <cstdint>
#define PROBE_PHASE -1
namespace pg8 {
#define PG8_LAS __attribute__((address_space(3)))
typedef unsigned short bf16_t;
typedef short bf16x8 __attribute__((ext_vector_type(8)));
typedef float f32x4 __attribute__((ext_vector_type(4)));
typedef unsigned u32x4 __attribute__((ext_vector_type(4)));
constexpr int BM = 256, BK = 64, HALF = 128, HTB = HALF * BK * 2  , STAGE_BYTES = 8 * HTB, NXCD = 8, WGM = 8;

__host__ __device__ __forceinline__ int lds_byte(int r, int c) { const int st = (r >> 4) * 2 + (c >> 5), rr = r & 15, cc = c & 31, ob = rr * 64 + cc * 2; return st * 1024 + (ob ^ (((ob >> 9) & 1) << 5)); }
__host__ __device__ __forceinline__ void stage_rc(int b, int& R, int& C) { const int st = b / 1024, sb = b % 1024, swz = sb ^ (((sb >> 9) & 1) << 5); R = (st >> 1) * 16 + swz / 64; C = (st & 1) * 32 + (swz % 64) / 2; }
__host__ __device__ __forceinline__ int perm32(int rho) { const int n = rho >> 4, i = rho & 15; return 8 * (i >> 2) + 4 * n + (i & 3); }

struct Unit { int pm, pn; };
struct Gemm { const bf16_t* A; const bf16_t* Bt; int M, N, K; };

struct StaticOrder {
    int nM, nN, nwg, G, c, wgm;
    __host__ __device__ void init(int M, int N, int G_, int c_, int wgm_ = WGM) { nM = M / BM; nN = N / BM; nwg = nM * nN; G = G_; c = c_; wgm = wgm_; }
    __host__ __device__ bool next(int i, Unit& u) const {
        const long L = (long)i * G + c; if (L >= nwg) return false;
        int wgid = (int)L; { const int q = nwg / NXCD, r = nwg % NXCD, xcd = wgid % NXCD, off = wgid / NXCD; wgid = (xcd < r ? xcd * (q + 1) : r * (q + 1) + (xcd - r) * q) + off; }
        const int nig = wgm * nN, gid = wgid / nig, fm = gid * wgm, gsz = (nM - fm) < wgm ? (nM - fm) : wgm;
        u.pm = fm + ((wgid % nig) % gsz); u.pn = (wgid % nig) / gsz; return true;
    }
    __device__ __forceinline__ void a_ready(const Unit&) const {}
    __device__ __forceinline__ void done(const Unit&) const {}
};

__device__ __forceinline__ unsigned cvt_pk_bf16(float lo, float hi) { unsigned r; asm volatile("v_cvt_pk_bf16_f32 %0, %1, %2" : "=v"(r) : "v"(lo), "v"(hi)); return r; }
__device__ __forceinline__ float bf2f(unsigned short h) { return __uint_as_float((unsigned)h << 16); }
__device__ __forceinline__ float sigmoidf_(float x) { return __builtin_amdgcn_rcpf(1.0f + __expf(-x)); }
__device__ __forceinline__ u32x4 pack8(const f32x4 a, const f32x4 b) { u32x4 w; w.x = cvt_pk_bf16(a[0], a[1]); w.y = cvt_pk_bf16(a[2], a[3]); w.z = cvt_pk_bf16(b[0], b[1]); w.w = cvt_pk_bf16(b[2], b[3]); return w; }
__device__ __forceinline__ void unpack8(const u32x4 w, f32x4& a, f32x4& b) {
    a[0] = __uint_as_float(w.x << 16); a[1] = __uint_as_float(w.x & 0xffff0000u); a[2] = __uint_as_float(w.y << 16); a[3] = __uint_as_float(w.y & 0xffff0000u);
    b[0] = __uint_as_float(w.z << 16); b[1] = __uint_as_float(w.z & 0xffff0000u); b[2] = __uint_as_float(w.w << 16); b[3] = __uint_as_float(w.w & 0xffff0000u); }

struct EpiInProj {
    static constexpr bool PERM = true, AFTER_DRAIN = false, HAS_MID = false;
    bf16_t* U; float* G; float* out_kp; float* out_vp; float* out_ks; float* out_vs; const float* lbl; int n_in, mp, mreal; float qscale;
    __device__ __forceinline__ void operator()(const f32x4 (&acc)[2][2][4][2], const Unit& u, int wr, int wc, int fr, int fq) const {
        const int pn = u.pn, row0 = u.pm * BM + wr * 64 + fr, colb = pn * BM + wc * 32 + 8 * fq;
        const int grp = pn >> 2;
        if (grp == 1) {
            float lb[2][8];
#pragma unroll
            for (int bj = 0; bj < 2; ++bj)
#pragma unroll
                for (int e = 0; e < 8; ++e) { const int c = colb + bj * HALF + e - 1024; const float l0 = lbl[c], l1 = lbl[1024 + c]; lb[bj][e] = 1.0f / (1.0f + expf(l1 - l0)); }
#pragma unroll
            for (int ai = 0; ai < 2; ++ai)
#pragma unroll
                for (int m = 0; m < 4; ++m) { const size_t row = (size_t)(row0 + ai * HALF + m * 16);
#pragma unroll
                    for (int bj = 0; bj < 2; ++bj) { f32x4 v0 = acc[ai][bj][m][0], v1 = acc[ai][bj][m][1], k0, k1;
#pragma unroll
                        for (int e = 0; e < 4; ++e) { const float s0 = __builtin_amdgcn_rcpf(1.0f + __expf(-v0[e])), s1 = __builtin_amdgcn_rcpf(1.0f + __expf(-v1[e])), a0 = 1.0f - lb[bj][e], a1 = 1.0f - lb[bj][4 + e];
                            v0[e] = __logf(lb[bj][e] + a0 * s0); v1[e] = __logf(lb[bj][4 + e] + a1 * s1); k0[e] = a0 * (1.0f - s0); k1[e] = a1 * (1.0f - s1); }
                        float* gp = G + row * 1024 + (colb + bj * HALF - 1024); *(f32x4*)gp = v0; *(f32x4*)(gp + 4) = v1;
                        *(u32x4*)(U + row * n_in + colb + bj * HALF) = pack8(k0, k1); } }
            return;
        }
#pragma unroll
        for (int ai = 0; ai < 2; ++ai)
#pragma unroll
            for (int m = 0; m < 4; ++m) { const int row = row0 + ai * HALF + m * 16;
#pragma unroll
                for (int bj = 0; bj < 2; ++bj) { f32x4 v0 = acc[ai][bj][m][0], v1 = acc[ai][bj][m][1]; const int col = colb + bj * HALF;
                    if (grp == 5 || grp == 6) {
                        float* o = nullptr;
                        if (row < mp) o = (grp == 5 ? out_kp : out_vp) + (size_t)row * 1024; else if (row < mreal) o = (grp == 5 ? out_ks : out_vs) + (size_t)(row - mp) * 1024;
                        if (o) { o += col - (grp == 5 ? 5120 : 6144); *(f32x4*)o = v0; *(f32x4*)(o + 4) = v1; }
                    } else if (grp == 3) {
#pragma unroll
                        for (int e = 0; e < 4; ++e) { v0[e] = v0[e] * sigmoidf_(v0[e]); v1[e] = v1[e] * sigmoidf_(v1[e]); }
                    } else if (grp == 4) { v0 = v0 * qscale; v1 = v1 * qscale; }
                    else if (grp >= 7) {
#pragma unroll
                        for (int e = 0; e < 4; ++e) { v0[e] = sigmoidf_(v0[e]); v1[e] = sigmoidf_(v1[e]); }
                    }
                    *(u32x4*)(U + (size_t)row * n_in + col) = pack8(v0, v1); } }
    }
};
struct EpiBf16Plain {
    static constexpr bool PERM = true, AFTER_DRAIN = false, HAS_MID = false;
    bf16_t* Y; int ldc;
    __device__ __forceinline__ void operator()(const f32x4 (&acc)[2][2][4][2], const Unit& u, int wr, int wc, int fr, int fq) const {
        const int row0 = u.pm * BM + wr * 64 + fr, colb = u.pn * BM + wc * 32 + 8 * fq;
#pragma unroll
        for (int ai = 0; ai < 2; ++ai)
#pragma unroll
            for (int m = 0; m < 4; ++m) { const size_t row = (size_t)(row0 + ai * HALF + m * 16);
#pragma unroll
                for (int bj = 0; bj < 2; ++bj) *(u32x4*)(Y + row * ldc + colb + bj * HALF) = pack8(acc[ai][bj][m][0], acc[ai][bj][m][1]); }
    }
};
struct EpiSwiGLU {
    static constexpr bool PERM = true, AFTER_DRAIN = false, HAS_MID = false;
    bf16_t* HID; int ldh;
    __device__ __forceinline__ void operator()(const f32x4 (&acc)[2][2][4][2], const Unit& u, int wr, int wc, int fr, int fq) const {
        const int row0 = u.pm * BM + wr * 64 + fr, col = u.pn * HALF + wc * 32 + 8 * fq;
#pragma unroll
        for (int ai = 0; ai < 2; ++ai)
#pragma unroll
            for (int m = 0; m < 4; ++m) { const size_t row = (size_t)(row0 + ai * HALF + m * 16);
                f32x4 a = acc[ai][0][m][0], b = acc[ai][0][m][1]; const f32x4 ua = acc[ai][1][m][0], ub = acc[ai][1][m][1];
#pragma unroll
                for (int e = 0; e < 4; ++e) { a[e] = a[e] * sigmoidf_(a[e]) * ua[e]; b[e] = b[e] * sigmoidf_(b[e]) * ub[e]; }
                *(u32x4*)(HID + row * ldh + col) = pack8(a, b); }
    }
};

struct EpiBranchCat {
    static constexpr bool PERM = true, AFTER_DRAIN = false, HAS_MID = true;
    const bf16_t* SGH; const bf16_t* SGD; int ldsg; bf16_t* MIX;
    __device__ __forceinline__ void mid(f32x4 (&acc)[2][2][4][2], const Unit& u, int wr, int wc, int fr, int fq) const {
        int opq = 0; asm volatile("" : "+v"(opq));
        const int row0 = u.pm * BM + wr * 64 + fr + opq, colb = u.pn * BM + wc * 32 + 8 * fq;
#define SC2_(A, lo, hw, dw) A[lo] *= __uint_as_float((hw) << 16) * __builtin_amdgcn_rcpf(fmaxf(__uint_as_float((dw) << 16), 1e-20f)); A[lo + 1] *= __uint_as_float((hw) & 0xffff0000u) * __builtin_amdgcn_rcpf(fmaxf(__uint_as_float((dw) & 0xffff0000u), 1e-20f))
#pragma unroll
        for (int ai = 0; ai < 2; ++ai) {
            u32x4 hw[4][2], dw[4][2];
#pragma unroll
            for (int m = 0; m < 4; ++m) { const size_t row = (size_t)(row0 + ai * HALF + m * 16);
#pragma unroll
                for (int bj = 0; bj < 2; ++bj) { const int col = colb + bj * HALF; hw[m][bj] = *(const u32x4*)(SGH + row * ldsg + col); dw[m][bj] = *(const u32x4*)(SGD + row * ldsg + col); } }
#pragma unroll
            for (int m = 0; m < 4; ++m)
#pragma unroll
                for (int bj = 0; bj < 2; ++bj) { SC2_(acc[ai][bj][m][0], 0, hw[m][bj].x, dw[m][bj].x); SC2_(acc[ai][bj][m][0], 2, hw[m][bj].y, dw[m][bj].y); SC2_(acc[ai][bj][m][1], 0, hw[m][bj].z, dw[m][bj].z); SC2_(acc[ai][bj][m][1], 2, hw[m][bj].w, dw[m][bj].w); }
            asm volatile("" ::: "memory"); }
#undef SC2_
    }
    __device__ __forceinline__ void operator()(const f32x4 (&acc)[2][2][4][2], const Unit& u, int wr, int wc, int fr, int fq) const {
        const int row0 = u.pm * BM + wr * 64 + fr, colb = u.pn * BM + wc * 32 + 8 * fq;
#pragma unroll
        for (int ai = 0; ai < 2; ++ai)
#pragma unroll
            for (int m = 0; m < 4; ++m) { const size_t row = (size_t)(row0 + ai * HALF + m * 16);
#pragma unroll
                for (int bj = 0; bj < 2; ++bj) { const int col = colb + bj * HALF; f32x4 d0, d1; unpack8(*(const u32x4*)(SGD + row * ldsg + col), d0, d1);
#pragma unroll
                    for (int e = 0; e < 4; ++e) { d0[e] = fmaxf(d0[e], 1e-20f); d1[e] = fmaxf(d1[e], 1e-20f); }
                    *(u32x4*)(MIX + row * 2048 + col) = pack8(acc[ai][bj][m][0] * d0, acc[ai][bj][m][1] * d1); } }
    }
};
template <class Epi, class Sched, bool ALIGN_EPI = false, bool SP2 = false>
__device__ __forceinline__ void gemm_phase(PG8_LAS unsigned char* lds, const Gemm g, const Sched& S, const Epi& E) {
    const int tid = threadIdx.x, wid = __builtin_amdgcn_readfirstlane(tid >> 6), lane = tid & 63, wr = wid >> 2, wc = wid & 3, fr = lane & 15, fq = lane >> 4;
    const int K = g.K, nt = K / BK;
    unsigned voffA[2], voffB[2];
#pragma unroll
    for (int i = 0; i < 2; ++i) { int R, C; stage_rc(tid * 16 + i * 8192, R, C); const int Rb = Epi::PERM ? ((R & ~31) + perm32(R & 31)) : R;
        voffA[i] = (unsigned)(R * K + C) * 2u; voffB[i] = (unsigned)(Rb * K + C) * 2u; }
    const size_t kstep = (size_t)(BK * 2);
    const size_t hstep = (size_t)HALF * K * 2;
    const size_t tstep = 2 * hstep;
    const unsigned ldsw = (unsigned)wid * 1024u;
    const int aoff = lds_byte(wr * 64 + fr, fq * 8), boff = lds_byte(wc * 32 + fr, fq * 8);
#define PG8_SA(b, h) (((b) * 2 + (h)) * HTB)
#define PG8_SB(b, h) ((4 + (b) * 2 + (h)) * HTB)
#define PG8_STAGE(bufoff, gbase, voff) do { _Pragma("unroll") for (int _i = 0; _i < 2; ++_i) \
        __builtin_amdgcn_global_load_lds((const unsigned*)((const char*)(gbase) + (voff)[_i]), (PG8_LAS unsigned*)(lds + (bufoff) + ldsw + _i * 8192), 16, 0, 0); } while (0)
#define PG8_LDA(dst, b, h) do { _Pragma("unroll") for (int m = 0; m < 4; ++m) _Pragma("unroll") for (int k = 0; k < 2; ++k) dst[m][k] = *(const PG8_LAS bf16x8*)(lds + PG8_SA(b, h) + aoff + m * 2048 + k * 1024); } while (0)
#define PG8_LDB(dst, b, h) do { _Pragma("unroll") for (int n = 0; n < 2; ++n) _Pragma("unroll") for (int k = 0; k < 2; ++k) dst[n][k] = *(const PG8_LAS bf16x8*)(lds + PG8_SB(b, h) + boff + n * 2048 + k * 1024); } while (0)
#define PG8_MMA(ai, bj, At, Bt) do { __builtin_amdgcn_s_setprio(1); _Pragma("unroll") for (int m = 0; m < 4; ++m) _Pragma("unroll") for (int n = 0; n < 2; ++n) _Pragma("unroll") for (int k = 0; k < 2; ++k) \
        acc[ai][bj][m][n] = __builtin_amdgcn_mfma_f32_16x16x32_bf16(Bt[n][k], At[m][k], acc[ai][bj][m][n], 0, 0, 0); __builtin_amdgcn_s_setprio(0); } while (0)
#define PG8_WAIT_V(n) asm volatile("s_waitcnt vmcnt(" #n ")" ::: "memory")
#define PG8_WAIT_L(n) asm volatile("s_waitcnt lgkmcnt(" #n ")" ::: "memory")
#define PG8_BAR __builtin_amdgcn_s_barrier()
#define PG8_SCHED __builtin_amdgcn_sched_barrier(0)
    Unit cur, nxt; int ui = 0;
    if (!S.next(0, cur)) return;
    f32x4 acc[2][2][4][2];
#pragma unroll
    for (int a = 0; a < 2; ++a)
#pragma unroll
        for (int b = 0; b < 2; ++b)
#pragma unroll
            for (int m = 0; m < 4; ++m)
#pragma unroll
                for (int n = 0; n < 2; ++n) acc[a][b][m][n] = (f32x4){0.f, 0.f, 0.f, 0.f};
    bf16x8 At[4][2], B0[2][2], B1[2][2];
    const char* cA = (const char*)g.A + (size_t)cur.pm * tstep; const char* cB = (const char*)g.Bt + (size_t)cur.pn * tstep;
    S.a_ready(cur);
    if constexpr (SP2) {
        PG8_STAGE(PG8_SB(0, 0), cB, voffB); PG8_STAGE(PG8_SB(0, 1), cB + hstep, voffB); PG8_STAGE(PG8_SA(0, 0), cA, voffA); PG8_STAGE(PG8_SA(0, 1), cA + hstep, voffA);
        if (wr == 1) PG8_BAR;
        PG8_WAIT_V(2); PG8_BAR;
        PG8_STAGE(PG8_SB(1, 0), cB + kstep, voffB); PG8_STAGE(PG8_SA(1, 0), cA + kstep, voffA); PG8_STAGE(PG8_SB(1, 1), cB + hstep + kstep, voffB);
        PG8_WAIT_V(6); PG8_BAR;
    } else {
        PG8_STAGE(PG8_SB(0, 0), cB, voffB); PG8_STAGE(PG8_SA(0, 0), cA, voffA); PG8_STAGE(PG8_SB(0, 1), cB + hstep, voffB); PG8_STAGE(PG8_SA(0, 1), cA + hstep, voffA);
        if (wr == 1) PG8_BAR;
        PG8_WAIT_V(4); PG8_BAR;
        PG8_STAGE(PG8_SB(1, 0), cB + kstep, voffB); PG8_STAGE(PG8_SA(1, 0), cA + kstep, voffA); PG8_STAGE(PG8_SB(1, 1), cB + hstep + kstep, voffB);
        PG8_WAIT_V(6); PG8_BAR;
    }
    for (;;) {
        const bool has_next = S.next(ui + 1, nxt);
        const char* nA = has_next ? (const char*)g.A + (size_t)nxt.pm * tstep : cA; const char* nB = has_next ? (const char*)g.Bt + (size_t)nxt.pn * tstep : cB;
        for (int t = 0; t < nt; t += 2) {
            const bool last = (t == nt - 2);
            const char* a1 = cA + (size_t)(t + 1) * kstep;
            const char* a2 = last ? nA : cA + (size_t)(t + 2) * kstep; const char* b2 = last ? nB : cB + (size_t)(t + 2) * kstep;
            const char* a3 = a2 + kstep; const char* b3 = b2 + kstep;
            if (last && has_next) S.a_ready(nxt);
            if constexpr (Epi::HAS_MID) { if (t == (nt >> 1)) E.mid(acc, cur, wr, wc, fr, fq); }
            if constexpr (SP2) {
            PG8_LDB(B0, 0, 0); PG8_LDB(B1, 0, 1); PG8_SCHED; PG8_LDA(At, 0, 0); PG8_STAGE(PG8_SA(1, 1), a1 + hstep, voffA);
            PG8_WAIT_V(8); PG8_WAIT_L(0); PG8_BAR; PG8_MMA(0, 0, At, B0); PG8_MMA(0, 1, At, B1); PG8_BAR; PG8_SCHED;
            PG8_LDA(At, 0, 1); PG8_STAGE(PG8_SB(0, 0), b2, voffB); PG8_STAGE(PG8_SB(0, 1), b2 + hstep, voffB); PG8_STAGE(PG8_SA(0, 0), a2, voffA);
            PG8_WAIT_V(8); PG8_WAIT_L(0); PG8_BAR; PG8_MMA(1, 0, At, B0); PG8_MMA(1, 1, At, B1); PG8_BAR; PG8_SCHED;
            PG8_LDB(B0, 1, 0); PG8_LDB(B1, 1, 1); PG8_SCHED; PG8_LDA(At, 1, 0); PG8_STAGE(PG8_SA(0, 1), a2 + hstep, voffA);
            PG8_WAIT_V(8); PG8_WAIT_L(0); PG8_BAR; PG8_MMA(0, 0, At, B0); PG8_MMA(0, 1, At, B1); PG8_BAR; PG8_SCHED;
            PG8_LDA(At, 1, 1); PG8_STAGE(PG8_SB(1, 0), b3, voffB); PG8_STAGE(PG8_SB(1, 1), b3 + hstep, voffB); PG8_STAGE(PG8_SA(1, 0), a3, voffA);
            PG8_WAIT_V(8); PG8_WAIT_L(0); PG8_BAR; PG8_MMA(1, 0, At, B0); PG8_MMA(1, 1, At, B1); PG8_BAR; PG8_SCHED;
            } else {
            PG8_LDB(B0, 0, 0); PG8_SCHED; PG8_LDA(At, 0, 0); PG8_STAGE(PG8_SA(1, 1), a1 + hstep, voffA);
            PG8_WAIT_L(8); PG8_BAR; PG8_WAIT_L(0); PG8_MMA(0, 0, At, B0); PG8_BAR; PG8_SCHED;
            PG8_LDB(B1, 0, 1); PG8_STAGE(PG8_SB(0, 0), b2, voffB);
            PG8_BAR; PG8_WAIT_L(0); PG8_MMA(0, 1, At, B1); PG8_BAR;
            PG8_LDA(At, 0, 1); PG8_STAGE(PG8_SA(0, 0), a2, voffA);
            PG8_BAR; PG8_WAIT_L(0); PG8_MMA(1, 0, At, B0); PG8_BAR; PG8_SCHED;
            PG8_STAGE(PG8_SB(0, 1), b2 + hstep, voffB);
            PG8_WAIT_V(6); PG8_BAR; PG8_MMA(1, 1, At, B1); PG8_BAR;
            PG8_LDB(B0, 1, 0); PG8_SCHED; PG8_LDA(At, 1, 0); PG8_STAGE(PG8_SA(0, 1), a2 + hstep, voffA);
            PG8_WAIT_L(8); PG8_BAR; PG8_WAIT_L(0); PG8_MMA(0, 0, At, B0); PG8_BAR; PG8_SCHED;
            PG8_LDB(B1, 1, 1); PG8_STAGE(PG8_SB(1, 0), b3, voffB);
            PG8_BAR; PG8_WAIT_L(0); PG8_MMA(0, 1, At, B1); PG8_BAR;
            PG8_LDA(At, 1, 1); PG8_STAGE(PG8_SA(1, 0), a3, voffA);
            PG8_BAR; PG8_WAIT_L(0); PG8_MMA(1, 0, At, B0); PG8_BAR; PG8_SCHED;
            PG8_STAGE(PG8_SB(1, 1), b3 + hstep, voffB);
            PG8_WAIT_V(6); PG8_BAR; PG8_MMA(1, 1, At, B1); PG8_BAR;
            }
        }
        if constexpr (ALIGN_EPI) { if (wr == 0) PG8_BAR; }
        if constexpr (!Epi::AFTER_DRAIN) { E(acc, cur, wr, wc, fr, fq); S.done(cur); }
        if (!has_next) break;
#pragma unroll
        for (int a = 0; a < 2; ++a)
#pragma unroll
            for (int b = 0; b < 2; ++b)
#pragma unroll
                for (int m = 0; m < 4; ++m)
#pragma unroll
                    for (int n = 0; n < 2; ++n) acc[a][b][m][n] = (f32x4){0.f, 0.f, 0.f, 0.f};
        cur = nxt; cA = nA; cB = nB; ++ui;
        if constexpr (ALIGN_EPI) { if (wr == 1) PG8_BAR; }
    }
    PG8_WAIT_V(0);
    if constexpr (!ALIGN_EPI) { if (wr == 0) PG8_BAR; }
    PG8_BAR;
    if constexpr (Epi::AFTER_DRAIN) { E.fused(acc, cur, wr, wc, fr, fq, lds, wid, lane); S.done(cur); }
#undef PG8_SA
#undef PG8_SB
#undef PG8_STAGE
#undef PG8_LDA
#undef PG8_LDB
#undef PG8_MMA
#undef PG8_WAIT_V
#undef PG8_WAIT_L
#undef PG8_BAR
#undef PG8_SCHED
}
}
#define GAS __attribute__((address_space(1)))
#define LAS __attribute__((address_space(3)))
typedef unsigned short bf16;
typedef unsigned v4u __attribute__((ext_vector_type(4)));
typedef float f32x4 __attribute__((ext_vector_type(4)));
typedef short bf16x8 __attribute__((ext_vector_type(8)));
typedef GAS unsigned gu32;
typedef GAS unsigned long long gu64;
#define RLX_AGENT __ATOMIC_RELAXED, __HIP_MEMORY_SCOPE_AGENT
#define LDS_WAIT() asm volatile("s_waitcnt lgkmcnt(0)" ::: "memory")
#define VM_WAIT() asm volatile("s_waitcnt vmcnt(0)" ::: "memory")
__device__ __forceinline__ unsigned long long rt() { return __builtin_amdgcn_s_memrealtime(); }
__device__ __forceinline__ unsigned f2bf(float f) { unsigned u = __builtin_bit_cast(unsigned, f); return (u + 0x7fffu + ((u >> 16) & 1u)) >> 16; }
__device__ __forceinline__ unsigned pk2(float lo, float hi) { return f2bf(lo) | (f2bf(hi) << 16); }
#define XB_TMO      128
#define XB_XCNT(j)  (256  + 64 * (j))
#define XB_XSUB(j)  (1280 + 64 * (j))
#define XB_XGEN(j)  (2304 + 64 * (j))
#define XB_TOP      3328
#define XB_TOPGEN   3392
#define XCD_BAR_WORDS 3456
#define XB_SPIN_CAP (1u << 18)

__device__ __forceinline__ unsigned xb_ld(unsigned* p)              { return __hip_atomic_load(p, __ATOMIC_RELAXED, __HIP_MEMORY_SCOPE_AGENT); }
__device__ __forceinline__ unsigned xb_add(unsigned* p, unsigned v) { return __hip_atomic_fetch_add(p, v, __ATOMIC_RELAXED, __HIP_MEMORY_SCOPE_AGENT); }
__device__ __forceinline__ unsigned xb_xcc_id() { return (unsigned)__builtin_amdgcn_s_getreg((3 << 11) | 20) & 0xFu; }
#define XB_SPIN(cond, bar) do { unsigned _sp = 0; while (cond) { __builtin_amdgcn_s_sleep(1); \
    if ((++_sp & 255u) == 0u) { if (xb_ld(&(bar)[XB_TMO])) break; if (_sp > XB_SPIN_CAP) { atomicAdd(&(bar)[XB_TMO], 1u); break; } } } } while (0)

struct XcdBarrier {
    unsigned* bar; unsigned x;
    volatile LAS unsigned* st;
};

__device__ __forceinline__ XcdBarrier xcd_barrier_post(unsigned* bar, volatile LAS unsigned* st) {
    XcdBarrier b; b.bar = bar; b.x = xb_xcc_id(); b.st = st;
    if (threadIdx.x == 0) (void)xb_add(&bar[XB_XCNT(b.x)], 1u);
    return b;
}
__device__ __forceinline__ void xcd_barrier_complete(unsigned* bar, unsigned x, unsigned& nloc, unsigned& nx) {
    const unsigned G = gridDim.x * gridDim.y * gridDim.z;
    unsigned sum, cnt, mine, sp = 0u;
    for (;;) {
        sum = 0u; cnt = 0u; mine = 0u;
#pragma unroll
        for (unsigned j = 0; j < 16; ++j) { const unsigned c = xb_ld(&bar[XB_XCNT(j)]); sum += c; cnt += (c > 0u) ? 1u : 0u; mine = (j == x) ? c : mine; }
        if (sum == G) break;
        __builtin_amdgcn_s_sleep(1);
        if ((++sp & 255u) == 0u) { if (xb_ld(&bar[XB_TMO])) break; if (sp > XB_SPIN_CAP) { atomicAdd(&bar[XB_TMO], 1u); break; } }
    }
    nloc = mine > 0u ? mine : 1u; nx = cnt > 0u ? cnt : 1u;
}

__device__ __forceinline__ void xcd_barrier(const XcdBarrier& b) {
    asm volatile("s_waitcnt vmcnt(0)" ::: "memory");
    __syncthreads();
    if (threadIdx.x == 0) {
        unsigned* bar = b.bar;
        __builtin_amdgcn_s_waitcnt(0);
        unsigned nloc = b.st[0], nx = b.st[1];
        if (nloc == 0u) { xcd_barrier_complete(bar, b.x, nloc, nx); b.st[0] = nloc; b.st[1] = nx; }
        const unsigned old = xb_add(&bar[XB_XSUB(b.x)], 1u);
        const unsigned gen = old / nloc;
        if (old + 1u == (gen + 1u) * nloc) {
            __builtin_amdgcn_fence(__ATOMIC_RELEASE, "agent");
            asm volatile("s_waitcnt vmcnt(0)" ::: "memory");
            const unsigned og = xb_add(&bar[XB_TOP], 1u);
            const unsigned tg = og / nx;
            if (og + 1u == (tg + 1u) * nx) xb_add(&bar[XB_TOPGEN], 1u);
            else XB_SPIN(xb_ld(&bar[XB_TOPGEN]) == tg, bar);
            __builtin_amdgcn_fence(__ATOMIC_ACQUIRE, "agent");
            xb_add(&bar[XB_XGEN(b.x)], 1u);
            asm volatile("s_waitcnt vmcnt(0)" ::: "memory");
        } else {
            XB_SPIN(xb_ld(&bar[XB_XGEN(b.x)]) == gen, bar);
            __builtin_amdgcn_fence(__ATOMIC_ACQUIRE, "agent");
            asm volatile("s_waitcnt vmcnt(0)" ::: "memory");
        }
    }
    __syncthreads();
}
constexpr int NWAVES = 8;
constexpr int DM = 2048, PB = 4, PL = 2048, MP = PB * PL, SB = 8, SL = 8, MS = SB * SL, MREAL = MP + MS, MT = 8448;
constexpr int NIN = 11264, DFF = 5632, NH = 8, HDK = 128, HDV = 128, DAH = 8, DADH = 64, DADV = 128;
constexpr int PAST = 16384, PAGE = 128, NPAGES = PAST / PAGE, NPOOL = 1280;
constexpr int C_HQ = 0, C_HF = 1024, C_HI = 2048, C_HGATE = 3072, C_DQ = 4096, C_DK = 5120, C_DV = 6144, C_GHG = 7168, C_GDA = 9216;
constexpr int OPITCH = 2048;
constexpr float RMS_EPS = 1e-6f, LOG2E = 1.4426950408889634f;
constexpr float QSCALE = 0.125f * LOG2E;
constexpr float LAM_INIT = 0.2f;
constexpr size_t O_YP = 0, O_YS = O_YP + (size_t)MP * DM, O_KP = O_YS + (size_t)MS * DM, O_VP = O_KP + (size_t)MP * 1024, O_SP = O_VP + (size_t)MP * 1024,
                 O_KS = O_SP + (size_t)PB * NH * HDK * HDV, O_VS = O_KS + (size_t)MS * 1024, O_SS = O_VS + (size_t)MS * 1024, O_END = O_SS + (size_t)SB * NH * HDK * HDV;
constexpr size_t MiB = 1u << 20;
constexpr size_t WS_CTL = 0, CTL_ZERO_BYTES = 1 * MiB;
constexpr size_t WS_WIN = 2 * MiB, WS_WBH = 48 * MiB, WS_WBD = 48 * MiB + 2048, WS_WOUT = 60 * MiB, WS_WUP = 70 * MiB, WS_WDN = 116 * MiB;
constexpr size_t WS_XN = 140 * MiB, WS_U = 176 * MiB, WS_G = 360 * MiB, WS_OHG = 396 * MiB, WS_ODA = 396 * MiB + 2048, WS_T1 = 432 * MiB, WS_MIX = 500 * MiB,
                 WS_Y1 = 536 * MiB, WS_X1 = 604 * MiB, WS_XN2 = 672 * MiB, WS_HID = 708 * MiB, WS_Y2 = 800 * MiB, WS_DEC = 868 * MiB, WS_X = 904 * MiB, WS_END = 906 * MiB;
static_assert(WS_WIN + (size_t)NIN * DM * 2 <= WS_WBH && WS_WUP + (size_t)NIN * DM * 2 <= WS_WDN && WS_WDN + (size_t)DM * DFF * 2 <= WS_XN && WS_XN + (size_t)MT * DM * 2 <= WS_U &&
              WS_U + (size_t)MT * NIN * 2 <= WS_G && WS_G + (size_t)MT * 1024 * 4 <= WS_OHG && WS_OHG + (size_t)MT * 2048 * 2 <= WS_T1 && WS_WBH + (size_t)DM * 2048 * 2 <= WS_WOUT &&
              WS_T1 + (size_t)MT * DM * 4 <= WS_MIX && WS_MIX + (size_t)MT * DM * 2 <= WS_Y1 && WS_Y1 + (size_t)MT * DM * 4 <= WS_X1 && WS_X1 + (size_t)MT * DM * 4 <= WS_XN2 &&
              WS_XN2 + (size_t)MT * DM * 2 <= WS_HID && WS_HID + (size_t)MT * DFF * 2 <= WS_Y2 && WS_Y2 + (size_t)MT * DM * 4 <= WS_DEC, "d_ws map");
constexpr int CW_TMO = 0, CW_CODE = 1, CW_Q = 64, CW_DCNT = 1024, CW_BAR = 4096, CW_SEAM = 40000, CW_THIN = 60000;
constexpr int RING_OFF = 0, RING_BYTES = 131072;
constexpr int LDSCTL_OFF = RING_BYTES, MISC_OFF = LDSCTL_OFF + 320;
constexpr int LDS_BYTES = 147456;
static_assert(MISC_OFF + 128 <= LDS_BYTES, "LDS map");
struct Args { const float* in[24]; const int* page_table; float* out; unsigned char* ws; int ph_lo, ph_hi, p2mask, pad; };
struct Frame {
    LAS unsigned char* lds; volatile LAS unsigned* MISC; gu32* ctl;
    int tid, lane, wave, vcu, G;
};
__device__ __forceinline__ float wave_sum(float v) {
#pragma unroll
    for (int o = 1; o < 64; o <<= 1) v += __shfl_xor(v, o);
    return v;
}
__device__ __forceinline__ float bf2f(bf16 h) { return __uint_as_float((unsigned)h << 16); }
__device__ __forceinline__ int t5_bucket(int n) {
    if (n < 16) return n;
    if (n >= 113) return 31;
    int b = 16;
    b += (n >= 19); b += (n >= 21); b += (n >= 24); b += (n >= 27); b += (n >= 31); b += (n >= 35); b += (n >= 40); b += (n >= 46);
    b += (n >= 52); b += (n >= 59); b += (n >= 67); b += (n >= 77); b += (n >= 87); b += (n >= 99);
    return b;
}
__device__ __forceinline__ float da_lambda(const Args& a) {
    float s1 = 0.f, s2 = 0.f;
    for (int i = 0; i < DADH; ++i) { s1 += a.in[13][i] * a.in[14][i]; s2 += a.in[15][i] * a.in[16][i]; }
    return expf(s1) - expf(s2) + LAM_INIT;
}
__device__ __forceinline__ void p0_transpose_item(const float* W, int K, int N, bf16* WT, int k0, int n0, int dst_row0, LAS float* scr, int lane, int ldt = 0) {
    if (ldt == 0) ldt = K;
#pragma unroll
    for (int i = 0; i < 8; ++i) { const int kk = 8 * i + (lane >> 3); const f32x4 t = *(const f32x4*)(W + (size_t)(k0 + kk) * N + n0 + 4 * (lane & 7));
        LAS float* d = scr + kk * 33 + 4 * (lane & 7); d[0] = t.x; d[1] = t.y; d[2] = t.z; d[3] = t.w; }
    LDS_WAIT(); asm volatile("" ::: "memory");
    const int c = lane & 7;
#pragma unroll
    for (int j = 0; j < 4; ++j) { const int n = (lane >> 3) + 8 * j; const LAS float* s = scr + (8 * c) * 33 + n;
        v4u o; o.x = pk2(s[0 * 33], s[1 * 33]); o.y = pk2(s[2 * 33], s[3 * 33]); o.z = pk2(s[4 * 33], s[5 * 33]); o.w = pk2(s[6 * 33], s[7 * 33]);
        *(GAS v4u*)(WT + (size_t)(dst_row0 + n) * ldt + k0 + 8 * c) = o; }
    LDS_WAIT(); asm volatile("" ::: "memory");
}
__device__ __forceinline__ void rms_row_to_bf16(const float* xrow, const float* w, bf16* orow, int lane) {
    GAS unsigned long long* o8 = (GAS unsigned long long*)orow + lane;
    if (!xrow) {
#pragma unroll
        for (int j = 0; j < 8; ++j) o8[64 * j] = 0ull;
        return; }
    const GAS f32x4* xr = (const GAS f32x4*)xrow + lane; const GAS f32x4* wr = (const GAS f32x4*)w + lane;
    f32x4 v[8]; float s = 0.f;
#pragma unroll
    for (int j = 0; j < 8; ++j) { v[j] = xr[64 * j]; s += (v[j].x * v[j].x + v[j].y * v[j].y) + (v[j].z * v[j].z + v[j].w * v[j].w); }
    const float rstd = 1.0f / sqrtf(wave_sum(s) * (1.0f / DM) + RMS_EPS);
#pragma unroll
    for (int j = 0; j < 8; ++j) { const f32x4 g = wr[64 * j]; o8[64 * j] = (unsigned long long)pk2(v[j].x * rstd * g.x, v[j].y * rstd * g.y) | ((unsigned long long)pk2(v[j].z * rstd * g.z, v[j].w * rstd * g.w) << 32); }
}
__device__ __forceinline__ void rms_rows2_to_bf16(const float* x0, const float* x1, bool has1, const float* w, bf16* o0, bf16* o1, int lane) {
    const GAS f32x4* wr = (const GAS f32x4*)w + lane;
    f32x4 v0[8], v1[8];
#pragma unroll
    for (int j = 0; j < 8; ++j) { v0[j] = x0 ? ((const GAS f32x4*)x0 + lane)[64 * j] : (f32x4){0.f, 0.f, 0.f, 0.f}; v1[j] = x1 ? ((const GAS f32x4*)x1 + lane)[64 * j] : (f32x4){0.f, 0.f, 0.f, 0.f}; }
    float s0 = 0.f, s1 = 0.f;
#pragma unroll
    for (int j = 0; j < 8; ++j) { s0 += (v0[j].x * v0[j].x + v0[j].y * v0[j].y) + (v0[j].z * v0[j].z + v0[j].w * v0[j].w); s1 += (v1[j].x * v1[j].x + v1[j].y * v1[j].y) + (v1[j].z * v1[j].z + v1[j].w * v1[j].w); }
    const float r0 = 1.0f / sqrtf(wave_sum(s0) * (1.0f / DM) + RMS_EPS), r1 = 1.0f / sqrtf(wave_sum(s1) * (1.0f / DM) + RMS_EPS);
    GAS unsigned long long* p0 = (GAS unsigned long long*)o0 + lane; GAS unsigned long long* p1 = (GAS unsigned long long*)o1 + lane;
#pragma unroll
    for (int j = 0; j < 8; ++j) { const f32x4 g = wr[64 * j];
        p0[64 * j] = (unsigned long long)pk2(v0[j].x * r0 * g.x, v0[j].y * r0 * g.y) | ((unsigned long long)pk2(v0[j].z * r0 * g.z, v0[j].w * r0 * g.w) << 32);
        if (has1) p1[64 * j] = (unsigned long long)pk2(v1[j].x * r1 * g.x, v1[j].y * r1 * g.y) | ((unsigned long long)pk2(v1[j].z * r1 * g.z, v1[j].w * r1 * g.w) << 32); }
}
__device__ __forceinline__ const float* x_row(const Args& a, int m) { return m < MP ? a.in[0] + (size_t)m * DM : (m < MREAL ? a.in[1] + (size_t)(m - MP) * DM : nullptr); }

constexpr int I_IN = (DM / 64) * (NIN / 32), I_BH = (1024 / 64) * (DM / 32), I_OUT = (DM / 64) * (DM / 32), I_UP = I_IN, I_DN = (DFF / 64) * (DM / 32);
constexpr int NITEMS_LATE = 2 * I_BH + I_OUT + I_UP;
struct XItem { const float* src; bf16* dst; int N, ldt; };
__device__ __forceinline__ XItem late_item(const Args& a, int r) {
    unsigned char* ws = a.ws; XItem x;
    if (r < I_BH) { const int nb = DM / 32, kb = r / nb, n0 = 32 * (r % nb); x.src = a.in[19] + (size_t)(64 * kb) * DM + n0; x.dst = (bf16*)(ws + WS_WBH) + (size_t)n0 * OPITCH + 64 * kb; x.N = DM; x.ldt = OPITCH; return x; } r -= I_BH;
    if (r < I_BH) { const int nb = DM / 32, kb = r / nb, n0 = 32 * (r % nb); x.src = a.in[20] + (size_t)(64 * kb) * DM + n0; x.dst = (bf16*)(ws + WS_WBD) + (size_t)n0 * OPITCH + 64 * kb; x.N = DM; x.ldt = OPITCH; return x; } r -= I_BH;
    if (r < I_OUT) { const int nb = DM / 32, kb = r / nb, n0 = 32 * (r % nb); x.src = a.in[21] + (size_t)(64 * kb) * DM + n0; x.dst = (bf16*)(ws + WS_WOUT) + (size_t)n0 * DM + 64 * kb; x.N = DM; x.ldt = DM; return x; } r -= I_OUT;
    { const int nb = NIN / 32, kb = r / nb, n0 = 32 * (r % nb);
      const int isup = n0 >= DFF, nn = isup ? n0 - DFF : n0, dr = 256 * (nn / 128) + (isup ? 128 : 0) + (nn % 128);
      x.src = a.in[22] + (size_t)(64 * kb) * NIN + n0; x.dst = (bf16*)(ws + WS_WUP) + (size_t)dr * DM + 64 * kb; x.N = NIN; x.ldt = DM; return x; }
}
__device__ __forceinline__ XItem dn_item(const Args& a, int r) { const int nb = DM / 32, kb = r / nb, n0 = 32 * (r % nb); XItem x; x.src = a.in[23] + (size_t)(64 * kb) * DM + n0; x.dst = (bf16*)(a.ws + WS_WDN) + (size_t)n0 * DFF + 64 * kb; x.N = DM; x.ldt = DFF; return x; }
__device__ __forceinline__ void x_load(const XItem& x, int lane, f32x4 (&t)[8]) {
#pragma unroll
    for (int i = 0; i < 8; ++i) t[i] = *(const GAS f32x4*)(x.src + (size_t)(8 * i + (lane >> 3)) * x.N + 4 * (lane & 7));
}
__device__ __forceinline__ void x_finish(const XItem& x, const f32x4 (&t)[8], LAS float* scr, int lane) {
#pragma unroll
    for (int i = 0; i < 8; ++i) { LAS float* d = scr + (8 * i + (lane >> 3)) * 33 + 4 * (lane & 7); d[0] = t[i].x; d[1] = t[i].y; d[2] = t[i].z; d[3] = t[i].w; }
    LDS_WAIT(); asm volatile("" ::: "memory");
    const int c = lane & 7;
#pragma unroll
    for (int j = 0; j < 4; ++j) { const int n = (lane >> 3) + 8 * j; const LAS float* s = scr + (8 * c) * 33 + n;
        v4u o; o.x = pk2(s[0 * 33], s[1 * 33]); o.y = pk2(s[2 * 33], s[3 * 33]); o.z = pk2(s[4 * 33], s[5 * 33]); o.w = pk2(s[6 * 33], s[7 * 33]);
        *(GAS v4u*)(x.dst + (size_t)n * x.ldt + 8 * c) = o; }
    LDS_WAIT(); asm volatile("" ::: "memory");
}
template <bool DN>
__device__ __forceinline__ void convert_from_counter(Frame& F, const Args& a, gu32* ctr) {
    constexpr int NIT = DN ? I_DN : NITEMS_LATE; static_assert(NIT % 8 == 0, "batches of 8");
    LAS float* scr = (LAS float*)(F.lds + RING_OFF + F.wave * 16384);
    for (;;) {
        unsigned it = 0; if (F.lane == 0) it = __hip_atomic_fetch_add(ctr, 8u, RLX_AGENT);
        it = (unsigned)__builtin_amdgcn_readfirstlane((int)it);
        if (it >= (unsigned)NIT) break;
        f32x4 ta[8], tb[8];
        XItem xa = DN ? dn_item(a, (int)it) : late_item(a, (int)it), xb;
        x_load(xa, F.lane, ta);
#pragma unroll
        for (int p = 0; p < 4; ++p) {
            xb = DN ? dn_item(a, (int)it + 2 * p + 1) : late_item(a, (int)it + 2 * p + 1); x_load(xb, F.lane, tb);
            x_finish(xa, ta, scr, F.lane);
            if (p < 3) { xa = DN ? dn_item(a, (int)it + 2 * p + 2) : late_item(a, (int)it + 2 * p + 2); x_load(xa, F.lane, ta); }
            x_finish(xb, tb, scr, F.lane);
        }
    }
}
__device__ __forceinline__ void convert_late(Frame& F, const Args& a, gu32* ctr) { convert_from_counter<false>(F, a, ctr); }
__device__ __forceinline__ void convert_dn(Frame& F, const Args& a, gu32* ctr) { convert_from_counter<true>(F, a, ctr); }
__device__ __forceinline__ void p0_prologue(Frame& F, const Args& a) {
    unsigned char* ws = a.ws;
    LAS float* scr = (LAS float*)(F.lds + RING_OFF + F.wave * 16384);
    const int gw = F.vcu * NWAVES + F.wave, NGW = F.G * NWAVES;
    for (int p = gw; p < I_IN / 2; p += NGW) {
        const int nb = NIN / 32; XItem xa, xb; f32x4 ta[8], tb[8];
        { const int it = 2 * p, kb = it / nb, n0 = 32 * (it % nb); xa.src = a.in[10] + (size_t)(64 * kb) * NIN + n0; xa.dst = (bf16*)(ws + WS_WIN) + (size_t)n0 * DM + 64 * kb; xa.N = NIN; xa.ldt = DM; }
        { const int it = 2 * p + 1, kb = it / nb, n0 = 32 * (it % nb); xb.src = a.in[10] + (size_t)(64 * kb) * NIN + n0; xb.dst = (bf16*)(ws + WS_WIN) + (size_t)n0 * DM + 64 * kb; xb.N = NIN; xb.ldt = DM; }
        x_load(xa, F.lane, ta); x_load(xb, F.lane, tb); x_finish(xa, ta, scr, F.lane); x_finish(xb, tb, scr, F.lane); }
    for (int m = gw; m < MT; m += 2 * NGW) rms_rows2_to_bf16(x_row(a, m), m + NGW < MT ? x_row(a, m + NGW) : nullptr, m + NGW < MT, a.in[6], (bf16*)(ws + WS_XN) + (size_t)m * DM, (bf16*)(ws + WS_XN) + (size_t)(m + NGW) * DM, F.lane);
    for (int m = MREAL + gw; m < MT; m += NGW) { rms_row_to_bf16(nullptr, nullptr, (bf16*)(ws + WS_OHG) + (size_t)m * OPITCH, F.lane); rms_row_to_bf16(nullptr, nullptr, (bf16*)(ws + WS_XN2) + (size_t)m * DM, F.lane); }
}
__device__ __forceinline__ f32x4 bf4(unsigned long long w) { const unsigned lo = (unsigned)w, hi = (unsigned)(w >> 32); return (f32x4){__uint_as_float(lo << 16), __uint_as_float(lo & 0xffff0000u), __uint_as_float(hi << 16), __uint_as_float(hi & 0xffff0000u)}; }
template <int NR>
__device__ __forceinline__ void row1(const Args& a, int m0, int stride, int lane) {
    unsigned char* ws = a.ws;
    const GAS f32x4* w1 = (const GAS f32x4*)a.in[7] + lane; const GAS f32x4* w2 = (const GAS f32x4*)a.in[8] + lane;
    unsigned long long yw[NR][8]; f32x4 xv[NR][8];
#pragma unroll
    for (int i = 0; i < NR; ++i) { const int m = m0 + i * stride; if (m < MREAL) {
        const GAS unsigned long long* yr = (const GAS unsigned long long*)((const bf16*)(ws + WS_Y1) + (size_t)m * DM) + lane; const GAS f32x4* xr = (const GAS f32x4*)x_row(a, m) + lane;
#pragma unroll
        for (int j = 0; j < 8; ++j) { yw[i][j] = yr[64 * j]; xv[i][j] = xr[64 * j]; } } }
    f32x4 g1[8];
#pragma unroll
    for (int j = 0; j < 8; ++j) g1[j] = w1[64 * j];
#pragma unroll
    for (int i = 0; i < NR; ++i) { const int m = m0 + i * stride; if (m < MREAL) {
        GAS unsigned long long* o8 = (GAS unsigned long long*)((bf16*)(ws + WS_XN2) + (size_t)m * DM) + lane; GAS unsigned long long* x1o = (GAS unsigned long long*)((bf16*)(ws + WS_X1) + (size_t)m * DM) + lane;
        float s = 0.f;
#pragma unroll
        for (int j = 0; j < 8; ++j) { const f32x4 v = bf4(yw[i][j]); s += (v.x * v.x + v.y * v.y) + (v.z * v.z + v.w * v.w); }
        const float rstd = 1.0f / sqrtf(wave_sum(s) * (1.0f / DM) + RMS_EPS); float s2 = 0.f;
#pragma unroll
        for (int j = 0; j < 8; ++j) { const f32x4 t = xv[i][j] + bf4(yw[i][j]) * rstd * g1[j]; xv[i][j] = t; x1o[64 * j] = (unsigned long long)pk2(t.x, t.y) | ((unsigned long long)pk2(t.z, t.w) << 32); s2 += (t.x * t.x + t.y * t.y) + (t.z * t.z + t.w * t.w); }
        const float rstd2 = 1.0f / sqrtf(wave_sum(s2) * (1.0f / DM) + RMS_EPS);
#pragma unroll
        for (int j = 0; j < 8; ++j) { const f32x4 g = w2[64 * j]; o8[64 * j] = (unsigned long long)pk2(xv[i][j].x * rstd2 * g.x, xv[i][j].y * rstd2 * g.y) | ((unsigned long long)pk2(xv[i][j].z * rstd2 * g.z, xv[i][j].w * rstd2 * g.w) << 32); } } }
}
template <int NR>
__device__ __forceinline__ void row2(const Args& a, int m0, int stride, int lane) {
    unsigned char* ws = a.ws;
    const GAS f32x4* w1 = (const GAS f32x4*)a.in[9] + lane;
    f32x4 v[NR][8]; unsigned long long xw[NR][8];
#pragma unroll
    for (int i = 0; i < NR; ++i) { const int m = m0 + i * stride; if (m < MREAL) {
        const GAS unsigned long long* yr = (const GAS unsigned long long*)((const bf16*)(ws + WS_Y2) + (size_t)m * DM) + lane; const GAS unsigned long long* xr = (const GAS unsigned long long*)((const bf16*)(ws + WS_X1) + (size_t)m * DM) + lane;
#pragma unroll
        for (int j = 0; j < 8; ++j) { v[i][j] = bf4(yr[64 * j]); xw[i][j] = xr[64 * j]; } } }
#pragma unroll
    for (int i = 0; i < NR; ++i) { const int m = m0 + i * stride; if (m < MREAL) {
        GAS f32x4* o = (GAS f32x4*)(m < MP ? a.out + O_YP + (size_t)m * DM : a.out + O_YS + (size_t)(m - MP) * DM) + lane;
        float s = 0.f;
#pragma unroll
        for (int j = 0; j < 8; ++j) s += (v[i][j].x * v[i][j].x + v[i][j].y * v[i][j].y) + (v[i][j].z * v[i][j].z + v[i][j].w * v[i][j].w);
        const float rstd = 1.0f / sqrtf(wave_sum(s) * (1.0f / DM) + RMS_EPS);
#pragma unroll
        for (int j = 0; j < 8; ++j) o[64 * j] = bf4(xw[i][j]) + v[i][j] * rstd * w1[64 * j]; } }
}
__device__ __forceinline__ void row_pass1(Frame& F, const Args& a) { int ln = threadIdx.x; asm volatile("" : "+v"(ln)); ln &= 63;
    const int gw = F.vcu * NWAVES + F.wave, NGW = F.G * NWAVES; for (int m = gw; m < MREAL; m += 3 * NGW) row1<3>(a, m, NGW, ln); }
__device__ __forceinline__ void row_pass2(Frame& F, const Args& a) { int ln = threadIdx.x; asm volatile("" : "+v"(ln)); ln &= 63;
    const int gw = F.vcu * NWAVES + F.wave, NGW = F.G * NWAVES; for (int m = gw; m < MREAL; m += 4 * NGW) row2<4>(a, m, NGW, ln); }
#ifndef PROBE_PHASE
#define PROBE_PHASE -1
#endif
#define HG_PROBE_MUL ((PROBE_PHASE == 23) ? 2 : 1)
namespace hg {
typedef short bf16x8 __attribute__((ext_vector_type(8)));
typedef short s16x4 __attribute__((ext_vector_type(4)));
typedef float f32x4 __attribute__((ext_vector_type(4)));
typedef float f32x2 __attribute__((ext_vector_type(2)));
typedef unsigned u32x2 __attribute__((ext_vector_type(2)));
typedef unsigned u32x4 __attribute__((ext_vector_type(4)));
constexpr int QS_P = 272, KT_P = 144, VS_P = 272, AM_P = 144, OB_P = 528;
constexpr int QS = 0, KS = QS + 64 * QS_P, KT = KS + 64 * QS_P, VS = KT + 128 * KT_P, AM = VS + 64 * VS_P, GS = AM + 64 * AM_P, DEC = GS + 8 * 128 * 4, NWL = DEC + 512, LDS_END = NWL + 512;
constexpr int OB = 0;
static_assert(64 * OB_P <= KT && LDS_END <= 131072, "hgrn LDS map");
__device__ __forceinline__ unsigned pkbf(float lo, float hi) { unsigned r; asm volatile("v_cvt_pk_bf16_f32 %0, %1, %2" : "=v"(r) : "v"(lo), "v"(hi)); return r; }
__device__ __forceinline__ float lo2f(unsigned w) { return __uint_as_float(w << 16); }
__device__ __forceinline__ float hi2f(unsigned w) { return __uint_as_float(w & 0xffff0000u); }
__device__ __forceinline__ s16x4 trd(const LAS unsigned char* p) { typedef short v4i16_t __attribute__((ext_vector_type(4))); return __builtin_bit_cast(s16x4, __builtin_amdgcn_ds_read_tr16_b64_v4i16((LAS v4i16_t*)p)); }
#define HG_BAR() do { asm volatile("s_waitcnt vmcnt(0) lgkmcnt(0)" ::: "memory"); __builtin_amdgcn_s_barrier(); asm volatile("" ::: "memory"); } while (0)
#define HG_LBAR() do { asm volatile("s_waitcnt lgkmcnt(0)" ::: "memory"); __builtin_amdgcn_s_barrier(); asm volatile("" ::: "memory"); } while (0)

__device__ __forceinline__ void prompt_unit(LAS unsigned char* lds, const Args& a, int b, int h) {
    int tid = threadIdx.x; asm volatile("" : "+v"(tid));
    const int lane = tid & 63, w = __builtin_amdgcn_readfirstlane(tid >> 6), q = lane >> 4, li = lane & 15;
    const bf16* U = (const bf16*)(a.ws + WS_U); const float* G = (const float*)(a.ws + WS_G); bf16* OHG = (bf16*)(a.ws + WS_OHG);
    const size_t rbase = (size_t)b * PL;
    if (tid < 128) ((LAS float*)(lds + NWL))[tid] = a.in[12][tid];
    f32x4 S[8];
#pragma unroll
    for (int i = 0; i < 8; ++i) S[i] = (f32x4){0.f, 0.f, 0.f, 0.f};
    f32x2 g2[8]; unsigned qv[8], kv[8]; u32x4 vv[2];
#define HG_PREFETCH(n) do { _Pragma("unroll") for (int r = 0; r < 8; ++r) { const size_t row = rbase + (size_t)(n) * 64 + 8 * w + r; \
            g2[r] = *(const f32x2*)(G + row * 1024 + h * HDK + 2 * lane); qv[r] = *(const unsigned*)(U + row * NIN + C_HQ + h * HDK + 2 * lane); kv[r] = *(const unsigned*)(U + row * NIN + C_HF + h * HDK + 2 * lane); } \
        { const bf16* vp = U + (rbase + (size_t)(n) * 64 + (tid >> 3)) * NIN + C_HI + h * HDV + (tid & 7) * 16; vv[0] = *(const u32x4*)vp; vv[1] = *(const u32x4*)(vp + 8); } } while (0)
    HG_PREFETCH(0);
    for (int nn = 0; nn < (PL / 64) * HG_PROBE_MUL; ++nn) { const int n = nn & (PL / 64 - 1);
        if (HG_PROBE_MUL > 1 && nn == PL / 64) {
#pragma unroll
            for (int i = 0; i < 8; ++i) S[i] = (f32x4){0.f, 0.f, 0.f, 0.f}; }
        float c0[8], c1[8];
        { float s0 = 0.f, s1 = 0.f;
#pragma unroll
          for (int r = 0; r < 8; ++r) { s0 += g2[r].x * LOG2E; s1 += g2[r].y * LOG2E; c0[r] = s0; c1[r] = s1; }
          *(LAS f32x2*)(lds + GS + (w * 128 + 2 * lane) * 4) = (f32x2){s0, s1}; }
        HG_LBAR();
        float off0 = 0.f, off1 = 0.f, tot0 = 0.f, tot1 = 0.f;
#pragma unroll
        for (int j = 0; j < 8; ++j) { const f32x2 t = *(const LAS f32x2*)(lds + GS + (j * 128 + 2 * lane) * 4); tot0 += t.x; tot1 += t.y; if (j < w) { off0 += t.x; off1 += t.y; } }
        const float dl0 = __builtin_amdgcn_exp2f(tot0), dl1 = __builtin_amdgcn_exp2f(tot1);
        if (w == 0) *(LAS f32x2*)(lds + DEC + 2 * lane * 4) = (f32x2){dl0, dl1};
        float kd0[8], kd1[8];
#pragma unroll
        for (int r = 0; r < 8; ++r) { const float G0 = off0 + c0[r], G1 = off1 + c1[r];
            const float e0 = __builtin_amdgcn_exp2f(G0), e1 = __builtin_amdgcn_exp2f(G1), i0 = __builtin_amdgcn_exp2f(-G0), i1 = __builtin_amdgcn_exp2f(-G1);
            const float kg0 = lo2f(kv[r]) * i0, kg1 = hi2f(kv[r]) * i1;
            *(LAS unsigned*)(lds + QS + (8 * w + r) * QS_P + lane * 4) = pkbf(lo2f(qv[r]) * e0, hi2f(qv[r]) * e1);
            *(LAS unsigned*)(lds + KS + (8 * w + r) * QS_P + lane * 4) = pkbf(kg0, kg1);
            kd0[r] = kg0 * dl0; kd1[r] = kg1 * dl1; }
        *(LAS u32x4*)(lds + KT + (2 * lane) * KT_P + w * 16) = (u32x4){pkbf(kd0[0], kd0[1]), pkbf(kd0[2], kd0[3]), pkbf(kd0[4], kd0[5]), pkbf(kd0[6], kd0[7])};
        *(LAS u32x4*)(lds + KT + (2 * lane + 1) * KT_P + w * 16) = (u32x4){pkbf(kd1[0], kd1[1]), pkbf(kd1[2], kd1[3]), pkbf(kd1[4], kd1[5]), pkbf(kd1[6], kd1[7])};
        *(LAS u32x4*)(lds + VS + (tid >> 3) * VS_P + (tid & 7) * 32) = vv[0]; *(LAS u32x4*)(lds + VS + (tid >> 3) * VS_P + (tid & 7) * 32 + 16) = vv[1];
        HG_LBAR();
        if (nn + 1 < (PL / 64) * HG_PROBE_MUL) HG_PREFETCH((n + 1) & (PL / 64 - 1));
        u32x4 gt0, gt1; { const bf16* gp = U + (rbase + (size_t)n * 64 + (tid >> 3)) * NIN + C_HGATE + h * HDV + (tid & 7) * 16; gt0 = *(const u32x4*)gp; gt1 = *(const u32x4*)(gp + 8); }
#pragma unroll
        for (int tt = 0; tt < 2; ++tt) { const int t = 2 * w + tt, ci = t >> 2, si = t & 3;
            f32x4 acc = (f32x4){0.f, 0.f, 0.f, 0.f};
#pragma unroll
            for (int kd = 0; kd < 4; ++kd) { const bf16x8 af = *(const LAS bf16x8*)(lds + KS + (16 * si + li) * QS_P + (32 * kd + 8 * q) * 2), bf = *(const LAS bf16x8*)(lds + QS + (16 * ci + li) * QS_P + (32 * kd + 8 * q) * 2);
                acc = __builtin_amdgcn_mfma_f32_16x16x32_bf16(af, bf, acc, 0, 0, 0); }
            const int cc = 16 * ci + li, sb = 16 * si + 4 * q;
#pragma unroll
            for (int r = 0; r < 4; ++r) if (sb + r > cc) acc[r] = 0.f;
            *(LAS u32x2*)(lds + AM + cc * AM_P + sb * 2) = (u32x2){pkbf(acc[0], acc[1]), pkbf(acc[2], acc[3])}; }
        f32x4 O[4];
#pragma unroll
        for (int m = 0; m < 4; ++m) O[m] = (f32x4){0.f, 0.f, 0.f, 0.f};
#pragma unroll
        for (int ks = 0; ks < 4; ++ks) { const u32x4 sb4 = (u32x4){pkbf(S[2 * ks][0], S[2 * ks][1]), pkbf(S[2 * ks][2], S[2 * ks][3]), pkbf(S[2 * ks + 1][0], S[2 * ks + 1][1]), pkbf(S[2 * ks + 1][2], S[2 * ks + 1][3])};
            const bf16x8 sb = __builtin_bit_cast(bf16x8, sb4);
#pragma unroll
            for (int m = 0; m < 4; ++m) { const u32x2 a0 = *(const LAS u32x2*)(lds + QS + (16 * m + li) * QS_P + (32 * ks + 4 * q) * 2), a1 = *(const LAS u32x2*)(lds + QS + (16 * m + li) * QS_P + (32 * ks + 16 + 4 * q) * 2);
                const bf16x8 af = __builtin_bit_cast(bf16x8, (u32x4){a0.x, a0.y, a1.x, a1.y});
                O[m] = __builtin_amdgcn_mfma_f32_16x16x32_bf16(af, sb, O[m], 0, 0, 0); } }
        bf16x8 Vf[2];
#pragma unroll
        for (int k2 = 0; k2 < 2; ++k2) { const LAS unsigned char* vp = lds + VS + (32 * k2 + 8 * q + (li >> 2)) * VS_P + (16 * w + 4 * (li & 3)) * 2;
            const s16x4 lo = trd(vp), hi = trd(vp + 4 * VS_P); Vf[k2] = (bf16x8){lo[0], lo[1], lo[2], lo[3], hi[0], hi[1], hi[2], hi[3]}; }
#pragma unroll
        for (int dt = 0; dt < 8; ++dt) { const f32x4 dc = *(const LAS f32x4*)(lds + DEC + (16 * dt + 4 * q) * 4); S[dt] = S[dt] * dc;
#pragma unroll
            for (int k2 = 0; k2 < 2; ++k2) { const bf16x8 af = *(const LAS bf16x8*)(lds + KT + (16 * dt + li) * KT_P + (32 * k2 + 8 * q) * 2);
                S[dt] = __builtin_amdgcn_mfma_f32_16x16x32_bf16(af, Vf[k2], S[dt], 0, 0, 0); } }
        HG_LBAR();
#pragma unroll
        for (int m = 0; m < 4; ++m)
#pragma unroll
            for (int k2 = 0; k2 < 2; ++k2) { if (32 * k2 > 16 * m + 15) continue;
                const bf16x8 af = *(const LAS bf16x8*)(lds + AM + (16 * m + li) * AM_P + (32 * k2 + 8 * q) * 2);
                O[m] = __builtin_amdgcn_mfma_f32_16x16x32_bf16(af, Vf[k2], O[m], 0, 0, 0); }
#pragma unroll
        for (int m = 0; m < 4; ++m)
#pragma unroll
            for (int r = 0; r < 4; ++r) *(LAS float*)(lds + OB + (16 * m + 4 * q + r) * OB_P + (16 * w + li) * 4) = O[m][r];
        HG_LBAR();
        { const int c = tid >> 3, sg = tid & 7; f32x4 x[4]; float ss = 0.f;
#pragma unroll
          for (int i = 0; i < 4; ++i) { x[i] = *(const LAS f32x4*)(lds + OB + c * OB_P + sg * 64 + i * 16); ss += (x[i][0] * x[i][0] + x[i][1] * x[i][1]) + (x[i][2] * x[i][2] + x[i][3] * x[i][3]); }
          ss += __shfl_xor(ss, 1); ss += __shfl_xor(ss, 2); ss += __shfl_xor(ss, 4);
          const float rstd = 1.0f / sqrtf(ss * (1.0f / HDV) + RMS_EPS);
          const unsigned gw[8] = {gt0.x, gt0.y, gt0.z, gt0.w, gt1.x, gt1.y, gt1.z, gt1.w}; unsigned ow[8];
#pragma unroll
          for (int i = 0; i < 4; ++i) { const f32x4 nw = *(const LAS f32x4*)(lds + NWL + (sg * 16 + i * 4) * 4);
              ow[2 * i] = pkbf(x[i][0] * rstd * nw[0] * lo2f(gw[2 * i]), x[i][1] * rstd * nw[1] * hi2f(gw[2 * i])); ow[2 * i + 1] = pkbf(x[i][2] * rstd * nw[2] * lo2f(gw[2 * i + 1]), x[i][3] * rstd * nw[3] * hi2f(gw[2 * i + 1])); }
          bf16* op = OHG + (rbase + (size_t)n * 64 + c) * OPITCH + h * HDV + sg * 16;
          *(u32x4*)op = (u32x4){ow[0], ow[1], ow[2], ow[3]}; *(u32x4*)(op + 8) = (u32x4){ow[4], ow[5], ow[6], ow[7]}; }
    }
#undef HG_PREFETCH
    float* So = a.out + O_SP + (size_t)(b * NH + h) * HDK * HDV;
#pragma unroll
    for (int dt = 0; dt < 8; ++dt)
#pragma unroll
        for (int r = 0; r < 4; ++r) So[(size_t)(16 * dt + 4 * q + r) * HDV + 16 * w + li] = S[dt][r];
    HG_BAR();
}

__device__ __forceinline__ void sample_unit(LAS unsigned char* lds, const Args& a, int s, int h) {
    int tid = threadIdx.x; asm volatile("" : "+v"(tid));
    const int v = tid & 127, dg = tid >> 7, lane = tid & 63, wave = tid >> 6;
    LAS float* Fd = (LAS float*)lds; LAS float* Qd = Fd + SL * 128; LAS float* Iv = Qd + SL * 128; LAS float* Gv = Iv + SL * 128; LAS float* red = Gv + SL * 128; LAS float* red2 = red + 512;
    const bf16* U = (const bf16*)(a.ws + WS_U); const float* G = (const float*)(a.ws + WS_G); bf16* OHG = (bf16*)(a.ws + WS_OHG);
    const float* S0 = a.in[4] + (size_t)(s * NH + h) * HDK * HDV; float* Sout = a.out + O_SS + (size_t)(s * NH + h) * HDK * HDV;
    float S[32];
#pragma unroll
    for (int i = 0; i < 32; ++i) S[i] = S0[(size_t)(dg * 32 + i) * HDV + v];
#pragma unroll
    for (int e = 0; e < 2; ++e) { const int idx = tid + 512 * e, t = idx >> 7, c = idx & 127; const size_t row = (size_t)(MP + s * SL + t);
        Fd[idx] = __expf(G[row * 1024 + h * HDK + c]); Qd[idx] = bf2f(U[row * NIN + C_HQ + h * HDK + c]); Iv[idx] = bf2f(U[row * NIN + C_HI + h * HDV + c]); Gv[idx] = bf2f(U[row * NIN + C_HGATE + h * HDV + c]); }
    const float nw = a.in[12][v];
    HG_LBAR();
    for (int t = 0; t < SL; ++t) {
        const float iv = Iv[t * 128 + v];
        float part = 0.f;
#pragma unroll
        for (int i4 = 0; i4 < 8; ++i4) { const f32x4 f4 = *(const LAS f32x4*)(Fd + t * 128 + dg * 32 + 4 * i4), q4 = *(const LAS f32x4*)(Qd + t * 128 + dg * 32 + 4 * i4);
#pragma unroll
            for (int e = 0; e < 4; ++e) { const int i = 4 * i4 + e; S[i] = f4[e] * S[i] + (1.0f - f4[e]) * iv; part += S[i] * q4[e]; } }
        red[dg * 128 + v] = part; HG_LBAR();
        const float o = (red[v] + red[128 + v]) + (red[256 + v] + red[384 + v]);
        if (dg == 0) { const float ss = wave_sum(o * o); if (lane == 0) red2[wave] = ss; }
        HG_LBAR();
        if (dg == 0) { const float rstd = 1.0f / sqrtf((red2[0] + red2[1]) * (1.0f / HDV) + RMS_EPS);
            OHG[(size_t)(MP + s * SL + t) * OPITCH + h * HDV + v] = (bf16)f2bf(o * rstd * nw * Gv[t * 128 + v]); }
    }
#pragma unroll
    for (int i = 0; i < 32; ++i) Sout[(size_t)(dg * 32 + i) * HDV + v] = S[i];
    HG_LBAR();
}
}
namespace at {
typedef short bf16x8 __attribute__((ext_vector_type(8)));
typedef short s16x4 __attribute__((ext_vector_type(4)));
typedef float f32x4 __attribute__((ext_vector_type(4)));
typedef unsigned u32x2 __attribute__((ext_vector_type(2)));
typedef unsigned u32x4 __attribute__((ext_vector_type(4)));
constexpr int KP = 144, VP = 288;
constexpr int K_BYTES = 64 * KP, V_BYTES = 64 * VP, STG = 2 * K_BYTES + V_BYTES;
constexpr int LUT = 2 * STG, WSC = LUT + 1024, LDS_END = WSC + 8 * 256;
static_assert(LDS_END <= 131072, "attention LDS map");
constexpr float NEG = -1e30f;
using hg::pkbf; using hg::trd; using hg::lo2f; using hg::hi2f;

__device__ __forceinline__ float gmax4(float x) {
    auto a = __builtin_amdgcn_permlane16_swap(__float_as_uint(x), __float_as_uint(x), false, false); x = fmaxf(__uint_as_float(a[0]), __uint_as_float(a[1]));
    auto b = __builtin_amdgcn_permlane32_swap(__float_as_uint(x), __float_as_uint(x), false, false); return fmaxf(__uint_as_float(b[0]), __uint_as_float(b[1]));
}
__device__ __forceinline__ void prompt_unit(LAS unsigned char* lds, const Args& a, int b, int h, int qb, float lam) {
    int tid = threadIdx.x; asm volatile("" : "+v"(tid));
    const int lane = tid & 63, w = __builtin_amdgcn_readfirstlane(tid >> 6), Q = lane >> 4, li = lane & 15;
    const bf16* U = (const bf16*)(a.ws + WS_U); bf16* ODA = (bf16*)(a.ws + WS_ODA);
    const size_t rbase = (size_t)b * PL;
    const int r0 = 128 * qb + 16 * w;
    const int NT = 2 * qb + 2;
    if (tid < 256) { const int mp = tid >> 7, d = tid & 127; ((LAS float*)(lds + LUT))[tid] = a.in[18][t5_bucket(d) * 16 + mp * 8 + h] * LOG2E; }
    const float c31a = a.in[18][31 * 16 + h] * LOG2E, c31b = a.in[18][31 * 16 + 8 + h] * LOG2E;
    bf16x8 qf[2][2];
#pragma unroll
    for (int mp = 0; mp < 2; ++mp)
#pragma unroll
        for (int ks = 0; ks < 2; ++ks) qf[mp][ks] = *(const bf16x8*)(U + (rbase + r0 + li) * NIN + C_DQ + (mp * 8 + h) * 64 + 32 * ks + 8 * Q);
    f32x4 OT[2][8];
#pragma unroll
    for (int mp = 0; mp < 2; ++mp)
#pragma unroll
        for (int vt = 0; vt < 8; ++vt) OT[mp][vt] = (f32x4){0.f, 0.f, 0.f, 0.f};
    float mref[2] = {0.f, 0.f};
    f32x4 LT[2] = {(f32x4){0.f, 0.f, 0.f, 0.f}, (f32x4){0.f, 0.f, 0.f, 0.f}};
    const bf16x8 ones = (bf16x8){0x3f80, 0x3f80, 0x3f80, 0x3f80, 0x3f80, 0x3f80, 0x3f80, 0x3f80};
    u32x4 st[4];
    const int srow = tid >> 3, sch = tid & 7;
#define AT_LOAD(t) do { const bf16* rp = U + (rbase + (size_t)(t) * 64 + srow) * NIN; \
        st[0] = *(const u32x4*)(rp + C_DK + h * 64 + sch * 8); st[1] = *(const u32x4*)(rp + C_DK + (8 + h) * 64 + sch * 8); \
        st[2] = *(const u32x4*)(rp + C_DV + h * 128 + sch * 16); st[3] = *(const u32x4*)(rp + C_DV + h * 128 + sch * 16 + 8); } while (0)
#define AT_STORE(buf) do { LAS unsigned char* sb = lds + (buf) * STG; \
        *(LAS u32x4*)(sb + srow * KP + sch * 16) = st[0]; *(LAS u32x4*)(sb + K_BYTES + srow * KP + sch * 16) = st[1]; \
        *(LAS u32x4*)(sb + 2 * K_BYTES + srow * VP + sch * 32) = st[2]; *(LAS u32x4*)(sb + 2 * K_BYTES + srow * VP + sch * 32 + 16) = st[3]; } while (0)
    AT_LOAD(0); AT_STORE(0);
    HG_LBAR();
    for (int t = 0; t < NT; ++t) {
        if (t + 1 < NT) AT_LOAD(t + 1);
        const int k0 = 64 * t;
        if (k0 <= r0 + 15) {
            const LAS unsigned char* sb = lds + (t & 1) * STG;
            const bool far = (r0 - (k0 + 63)) >= 113;
            u32x4 pb[2][2];
#pragma unroll
            for (int mp = 0; mp < 2; ++mp) {
                const float cinit = (far ? (mp ? c31b : c31a) : 0.f) - mref[mp];
                f32x4 s[4];
#pragma unroll
                for (int i = 0; i < 4; ++i) { s[i] = (f32x4){cinit, cinit, cinit, cinit};
#pragma unroll
                    for (int ks = 0; ks < 2; ++ks) { const bf16x8 kf = *(const LAS bf16x8*)(sb + mp * K_BYTES + (16 * i + li) * KP + (32 * ks + 8 * Q) * 2);
                        s[i] = __builtin_amdgcn_mfma_f32_16x16x32_bf16(kf, qf[mp][ks], s[i], 0, 0, 0); } }
                if (!far) {
                    const LAS float* lut = (const LAS float*)(lds + LUT) + mp * 128;
#pragma unroll
                    for (int i = 0; i < 4; ++i)
#pragma unroll
                        for (int r = 0; r < 4; ++r) { const int dist = (r0 + li) - (k0 + 16 * i + 4 * Q + r); const int di = dist < 0 ? 0 : (dist > 127 ? 127 : dist);
                            const float v = s[i][r] + lut[di]; s[i][r] = dist < 0 ? NEG : v; }
                }
                float mx = fmaxf(fmaxf(fmaxf(s[0][0], s[0][1]), fmaxf(s[0][2], s[0][3])), fmaxf(fmaxf(s[1][0], s[1][1]), fmaxf(s[1][2], s[1][3])));
                mx = fmaxf(mx, fmaxf(fmaxf(fmaxf(s[2][0], s[2][1]), fmaxf(s[2][2], s[2][3])), fmaxf(fmaxf(s[3][0], s[3][1]), fmaxf(s[3][2], s[3][3]))));
                mx = gmax4(mx);
                const float delta = (t == 0) ? mx : fmaxf(mx, 0.f);
                if (__any(delta != 0.f)) {
                    const float alpha = __builtin_amdgcn_exp2f(-delta); mref[mp] += delta;
#pragma unroll
                    for (int i = 0; i < 4; ++i) s[i] = s[i] - delta;
#pragma unroll
                    for (int vt = 0; vt < 8; ++vt) OT[mp][vt] = OT[mp][vt] * alpha;
                    LT[mp] = LT[mp] * alpha; }
#pragma unroll
                for (int i = 0; i < 4; ++i)
#pragma unroll
                    for (int r = 0; r < 4; ++r) s[i][r] = __builtin_amdgcn_exp2f(s[i][r]);
                pb[mp][0] = (u32x4){pkbf(s[0][0], s[0][1]), pkbf(s[0][2], s[0][3]), pkbf(s[1][0], s[1][1]), pkbf(s[1][2], s[1][3])};
                pb[mp][1] = (u32x4){pkbf(s[2][0], s[2][1]), pkbf(s[2][2], s[2][3]), pkbf(s[3][0], s[3][1]), pkbf(s[3][2], s[3][3])};
                LT[mp] = __builtin_amdgcn_mfma_f32_16x16x32_bf16(ones, __builtin_bit_cast(bf16x8, pb[mp][0]), LT[mp], 0, 0, 0);
                LT[mp] = __builtin_amdgcn_mfma_f32_16x16x32_bf16(ones, __builtin_bit_cast(bf16x8, pb[mp][1]), LT[mp], 0, 0, 0);
            }
            const LAS unsigned char* vb = sb + 2 * K_BYTES;
#pragma unroll
            for (int T = 0; T < 2; ++T)
#pragma unroll
                for (int vt = 0; vt < 8; ++vt) { const LAS unsigned char* vp = vb + (32 * T + 4 * Q + (li >> 2)) * VP + (16 * vt + 4 * (li & 3)) * 2;
                    const s16x4 lo = trd(vp), hi = trd(vp + 16 * VP); const bf16x8 vf = (bf16x8){lo[0], lo[1], lo[2], lo[3], hi[0], hi[1], hi[2], hi[3]};
                    OT[0][vt] = __builtin_amdgcn_mfma_f32_16x16x32_bf16(vf, __builtin_bit_cast(bf16x8, pb[0][T]), OT[0][vt], 0, 0, 0);
                    OT[1][vt] = __builtin_amdgcn_mfma_f32_16x16x32_bf16(vf, __builtin_bit_cast(bf16x8, pb[1][T]), OT[1][vt], 0, 0, 0); }
        }
        if (t + 1 < NT) AT_STORE((t + 1) & 1);
        HG_LBAR();
    }
#undef AT_LOAD
#undef AT_STORE
    const float l0 = LT[0][0], l1 = LT[1][0];
    const float i0 = 1.0f / l0, i1 = lam / l1; float ss = 0.f;
#pragma unroll
    for (int vt = 0; vt < 8; ++vt) { OT[0][vt] = OT[0][vt] * i0 - OT[1][vt] * i1; ss += (OT[0][vt][0] * OT[0][vt][0] + OT[0][vt][1] * OT[0][vt][1]) + (OT[0][vt][2] * OT[0][vt][2] + OT[0][vt][3] * OT[0][vt][3]); }
    ss += __shfl_xor(ss, 16); ss += __shfl_xor(ss, 32);
    const float rstd = (1.0f - LAM_INIT) / sqrtf(ss * (1.0f / DADV) + RMS_EPS);
    bf16* op = ODA + (rbase + r0 + li) * OPITCH + h * DADV + 4 * Q;
#pragma unroll
    for (int vt = 0; vt < 8; ++vt) { const f32x4 wv = *(const f32x4*)(a.in[17] + 16 * vt + 4 * Q); const f32x4 o = OT[0][vt] * rstd * wv;
        *(u32x2*)(op + 16 * vt) = (u32x2){pkbf(o[0], o[1]), pkbf(o[2], o[3])}; }
}
}
namespace dc {
typedef short bf16x8 __attribute__((ext_vector_type(8)));
typedef short s16x4 __attribute__((ext_vector_type(4)));
typedef float f32x4 __attribute__((ext_vector_type(4)));
typedef unsigned u32x2 __attribute__((ext_vector_type(2)));
typedef unsigned u32x4 __attribute__((ext_vector_type(4)));
constexpr int NPG = 2, NSPLIT = NPAGES / NPG;
constexpr int VP = 288, WREG = 32 * VP, FLAG = 8 * WREG, LDS_END = FLAG + 64;
constexpr size_t PM_OFF = 0, PL_OFF = (size_t)SB * NH * 16 * NSPLIT * 4, PO_OFF = 2 * PL_OFF, PO_BYTES = (size_t)SB * NSPLIT * NH * 16 * 128 * 4;
static_assert(WS_DEC + PO_OFF + PO_BYTES <= WS_END && LDS_END <= 131072, "decode maps");
constexpr float NEG = -1e30f;
using hg::pkbf; using hg::trd;
__device__ __forceinline__ f32x4 ldnt(const float* p) { return __builtin_nontemporal_load((const f32x4*)p); }

__device__ __forceinline__ void combine_task(LAS unsigned char* lds, const Args& a, gu32* cnt, int s, int h, float lam) {
    int tid = threadIdx.x; asm volatile("" : "+v"(tid));
    const int lane = tid & 63, w = __builtin_amdgcn_readfirstlane(tid >> 6), Q = lane >> 4, li = lane & 15, mp = li >> 3, j = li & 7;
    if (tid < 64) { unsigned sp = 0; while ((unsigned)__builtin_amdgcn_readfirstlane((int)__hip_atomic_load(cnt + 64 * s, RLX_AGENT)) < (unsigned)NSPLIT) { __builtin_amdgcn_s_sleep(2); if (++sp > (1u << 22)) break; }
        __builtin_amdgcn_fence(__ATOMIC_ACQUIRE, "agent"); asm volatile("s_waitcnt vmcnt(0)" ::: "memory"); }
    __syncthreads();
    const bf16* U = (const bf16*)(a.ws + WS_U); bf16* ODA = (bf16*)(a.ws + WS_ODA);
    const float* PM = (const float*)(a.ws + WS_DEC + PM_OFF) + (size_t)((s * NH + h) * 16 + li) * NSPLIT; const float* PLs = (const float*)(a.ws + WS_DEC + PL_OFF) + (size_t)((s * NH + h) * 16 + li) * NSPLIT;
    const float* PO = (const float*)(a.ws + WS_DEC + PO_OFF);
    float sn[8];
    { f32x4 qv[16]; const bf16* qp = U + (size_t)(MP + s * SL + j) * NIN + C_DQ + (mp * 8 + h) * 64;
#pragma unroll
      for (int c = 0; c < 8; ++c) { const u32x4 t = *(const u32x4*)(qp + 8 * c); qv[2 * c] = (f32x4){hg::lo2f(t.x), hg::hi2f(t.x), hg::lo2f(t.y), hg::hi2f(t.y)}; qv[2 * c + 1] = (f32x4){hg::lo2f(t.z), hg::hi2f(t.z), hg::lo2f(t.w), hg::hi2f(t.w)}; }
#pragma unroll
      for (int jj = 0; jj < 8; ++jj) { const float* kp = a.out + O_KS + (size_t)(s * SL + jj) * 1024 + (mp * 8 + h) * 64; float sc = 0.f;
#pragma unroll
          for (int c = 0; c < 16; ++c) { const f32x4 kv = *(const f32x4*)(kp + 4 * c); sc += (qv[c][0] * kv[0] + qv[c][1] * kv[1]) + (qv[c][2] * kv[2] + qv[c][3] * kv[3]); }
          const int dist = j - jj; sc += a.in[18][(dist < 0 ? 0 : dist) * 16 + mp * 8 + h] * LOG2E;
          sn[jj] = dist < 0 ? NEG : sc; __builtin_amdgcn_sched_barrier(0); } }
    float mstar = NEG;
#pragma unroll
    for (int c = 0; c < NSPLIT / 4; ++c) { const f32x4 t = *(const f32x4*)(PM + 4 * c); mstar = fmaxf(mstar, fmaxf(fmaxf(t[0], t[1]), fmaxf(t[2], t[3]))); }
#pragma unroll
    for (int jj = 0; jj < 8; ++jj) mstar = fmaxf(mstar, sn[jj]);
    f32x4 acc[8]; float lsum = 0.f;
#pragma unroll
    for (int vt = 0; vt < 8; ++vt) acc[vt] = (f32x4){0.f, 0.f, 0.f, 0.f};
    static_assert(NSPLIT == 64, "8 waves x 8 splits");
#pragma unroll 1
    for (int c = 0; c < 4; ++c) { const float m0 = PM[8 * w + 2 * c], m1 = PM[8 * w + 2 * c + 1], l0 = PLs[8 * w + 2 * c], l1 = PLs[8 * w + 2 * c + 1];
        f32x4 ov[2][8];
#pragma unroll
        for (int e = 0; e < 2; ++e) { const float* op = PO + ((((size_t)s * NSPLIT + (8 * w + 2 * c + e)) * NH + h) * 16 + li) * 128 + 4 * Q;
#pragma unroll
            for (int vt = 0; vt < 8; ++vt) ov[e][vt] = *(const f32x4*)(op + 16 * vt); }
        const float w0 = __builtin_amdgcn_exp2f(m0 - mstar), w1 = __builtin_amdgcn_exp2f(m1 - mstar); lsum += w0 * l0 + w1 * l1;
#pragma unroll
        for (int vt = 0; vt < 8; ++vt) acc[vt] += ov[0][vt] * w0 + ov[1][vt] * w1; }
    if (w == 0) {
#pragma unroll
        for (int jj = 0; jj < 8; ++jj) { const float p = __builtin_amdgcn_exp2f(sn[jj] - mstar); lsum += p; const float* vp = a.out + O_VS + (size_t)(s * SL + jj) * 1024 + h * 128 + 4 * Q;
#pragma unroll
            for (int vt = 0; vt < 8; ++vt) acc[vt] += *(const f32x4*)(vp + 16 * vt) * p; } }
    LAS float* P = (LAS float*)lds;
#pragma unroll
    for (int vt = 0; vt < 8; ++vt)
#pragma unroll
        for (int r = 0; r < 4; ++r) P[(w * 33 + vt * 4 + r) * 64 + lane] = acc[vt][r];
    P[(w * 33 + 32) * 64 + lane] = lsum;
    HG_LBAR();
    if (w == 0) {
        lsum = 0.f;
#pragma unroll
        for (int ww = 0; ww < 8; ++ww) lsum += P[(ww * 33 + 32) * 64 + lane];
        const float sc = (mp ? -lam : 1.0f) / lsum; float ss = 0.f;
#pragma unroll
        for (int vt = 0; vt < 8; ++vt) { f32x4 o;
#pragma unroll
            for (int r = 0; r < 4; ++r) { float t = 0.f;
#pragma unroll
                for (int ww = 0; ww < 8; ++ww) t += P[(ww * 33 + vt * 4 + r) * 64 + lane];
                t *= sc; t += __shfl_xor(t, 8); o[r] = t; }
            acc[vt] = o; ss += (o[0] * o[0] + o[1] * o[1]) + (o[2] * o[2] + o[3] * o[3]); }
        ss += __shfl_xor(ss, 16); ss += __shfl_xor(ss, 32);
        const float rstd = (1.0f - LAM_INIT) / sqrtf(ss * (1.0f / DADV) + RMS_EPS);
        if (mp == 0) { bf16* op = ODA + (size_t)(MP + s * SL + j) * OPITCH + h * DADV + 4 * Q;
#pragma unroll
            for (int vt = 0; vt < 8; ++vt) { const f32x4 wv = *(const f32x4*)(a.in[17] + 16 * vt + 4 * Q); const f32x4 o = acc[vt] * rstd * wv; *(u32x2*)(op + 16 * vt) = (u32x2){pkbf(o[0], o[1]), pkbf(o[2], o[3])}; } }
    }
    HG_LBAR();
}

__device__ __forceinline__ void unit(LAS unsigned char* lds, const Args& a, gu32* cnt, int s, int g, float lam) {
    int tid = threadIdx.x; asm volatile("" : "+v"(tid));
    const int lane = tid & 63, h = __builtin_amdgcn_readfirstlane(tid >> 6), Q = lane >> 4, li = lane & 15, mp = li >> 3, j = li & 7;
    const bf16* U = (const bf16*)(a.ws + WS_U);
    LAS unsigned char* wreg = lds + h * WREG;
    const float c31 = a.in[18][31 * 16 + mp * 8 + h] * LOG2E;
    bf16x8 qf[2];
#pragma unroll
    for (int ks = 0; ks < 2; ++ks) qf[ks] = *(const bf16x8*)(U + (size_t)(MP + s * SL + j) * NIN + C_DQ + (mp * 8 + h) * 64 + 32 * ks + 8 * Q);
    f32x4 OT[8];
#pragma unroll
    for (int vt = 0; vt < 8; ++vt) OT[vt] = (f32x4){0.f, 0.f, 0.f, 0.f};
    float mrun = NEG, lrun = 0.f;
#pragma unroll 1
    for (int pg = 0; pg < NPG; ++pg) {
        const int lp = g * NPG + pg, page = a.page_table[s * NPAGES + lp];
        const __amdgpu_buffer_rsrc_t krs = __builtin_amdgcn_make_buffer_rsrc((void*)(a.in[2] + (size_t)page * PAGE * 1024), 0, PAGE * 1024 * 4, 0x00020000);
        const __amdgpu_buffer_rsrc_t vrs = __builtin_amdgcn_make_buffer_rsrc((void*)(a.in[3] + (size_t)page * PAGE * 1024), 0, PAGE * 1024 * 4, 0x00020000);
        const int kvo = ((lane >> 4) * 1024 + h * 64 + (lane & 15) * 4) * 4;
        const int vvo = ((lane >> 5) * 1024 + h * 128 + (lane & 31) * 4) * 4;
        f32x4 kr[8];
#define DC_LD(rs, vo, so) __builtin_bit_cast(f32x4, __builtin_amdgcn_raw_buffer_load_b128(rs, vo, so, 0))
#define DC_KLOAD(dst, i) do { const int so_ = 16 * (i) * 4096; \
            dst[0] = DC_LD(krs, kvo, so_); dst[1] = DC_LD(krs, kvo, so_ + 4 * 4096); dst[2] = DC_LD(krs, kvo, so_ + 8 * 4096); dst[3] = DC_LD(krs, kvo, so_ + 12 * 4096); \
            dst[4] = DC_LD(krs, kvo, so_ + 2048); dst[5] = DC_LD(krs, kvo, so_ + 4 * 4096 + 2048); dst[6] = DC_LD(krs, kvo, so_ + 8 * 4096 + 2048); dst[7] = DC_LD(krs, kvo, so_ + 12 * 4096 + 2048); } while (0)
        constexpr int KRP = 144, KMAP = 16 * KRP, KSLAB = 2 * KMAP; static_assert(2 * KSLAB <= WREG, "K slabs inside the wave's V stage");
        LAS unsigned char* kwr = wreg + (lane >> 4) * KRP + (lane & 15) * 8; const LAS unsigned char* kfr = wreg + li * KRP + 16 * Q;
#define DC_KPARK(src, i) do { _Pragma("unroll") for (int n_ = 0; n_ < 8; ++n_) *(LAS u32x2*)(kwr + ((i) & 1) * KSLAB + (n_ >> 2) * KMAP + 4 * (n_ & 3) * KRP) = (u32x2){pkbf(src[n_][0], src[n_][1]), pkbf(src[n_][2], src[n_][3])}; } while (0)
#define DC_KF(i, m, ks) (*(const LAS bf16x8*)(kfr + ((i) & 1) * KSLAB + (m) * KMAP + 64 * (ks)))
        f32x4 S[8];
        DC_KLOAD(kr, 0);
#pragma unroll
        for (int i = 0; i < 8; ++i) {
            DC_KPARK(kr, i);
            if (i + 1 < 8) DC_KLOAD(kr, i + 1);
            asm volatile("s_waitcnt lgkmcnt(0)" ::: "memory");
            const bf16x8 k00 = DC_KF(i, 0, 0), k01 = DC_KF(i, 0, 1), k10 = DC_KF(i, 1, 0), k11 = DC_KF(i, 1, 1);
            const f32x4 z = (f32x4){0.f, 0.f, 0.f, 0.f};
            f32x4 t1 = __builtin_amdgcn_mfma_f32_16x16x32_bf16(k00, qf[0], z, 0, 0, 0); t1 = __builtin_amdgcn_mfma_f32_16x16x32_bf16(k01, qf[1], t1, 0, 0, 0);
            f32x4 t2 = __builtin_amdgcn_mfma_f32_16x16x32_bf16(k10, qf[0], z, 0, 0, 0); t2 = __builtin_amdgcn_mfma_f32_16x16x32_bf16(k11, qf[1], t2, 0, 0, 0);
            S[i] = mp ? t2 : t1;
            __builtin_amdgcn_sched_barrier(0);
        }
        f32x4 vr[16];
#define DC_VLOAD(T) do { _Pragma("unroll") for (int n_ = 0; n_ < 16; ++n_) vr[n_] = DC_LD(vrs, vvo, (32 * (T) + 2 * n_) * 4096); } while (0)
        DC_VLOAD(0);
        if (lp == NPAGES - 1) {
#pragma unroll
            for (int i = 0; i < 8; ++i)
#pragma unroll
                for (int r = 0; r < 4; ++r) { const int dist = PAST + j - (lp * PAGE + 16 * i + 4 * Q + r); S[i][r] += a.in[18][t5_bucket(dist) * 16 + mp * 8 + h] * LOG2E; }
        } else {
#pragma unroll
            for (int i = 0; i < 8; ++i) S[i] = S[i] + c31;
        }
        float mx = NEG;
#pragma unroll
        for (int i = 0; i < 8; ++i) mx = fmaxf(mx, fmaxf(fmaxf(S[i][0], S[i][1]), fmaxf(S[i][2], S[i][3])));
        mx = fmaxf(mx, __shfl_xor(mx, 16)); mx = fmaxf(mx, __shfl_xor(mx, 32));
        const float mn = fmaxf(mrun, mx), alpha = __builtin_amdgcn_exp2f(mrun - mn); mrun = mn;
        float ps = 0.f;
#pragma unroll
        for (int i = 0; i < 8; ++i)
#pragma unroll
            for (int r = 0; r < 4; ++r) { S[i][r] = __builtin_amdgcn_exp2f(S[i][r] - mn); ps += S[i][r]; }
        lrun = lrun * alpha + ps;
#pragma unroll
        for (int vt = 0; vt < 8; ++vt) OT[vt] = OT[vt] * alpha;
#pragma unroll
        for (int T = 0; T < 4; ++T) {
#pragma unroll
            for (int n = 0; n < 16; ++n) *(LAS u32x2*)(wreg + (2 * n + (lane >> 5)) * VP + (lane & 31) * 8) = (u32x2){pkbf(vr[n][0], vr[n][1]), pkbf(vr[n][2], vr[n][3])};
            if (T + 1 < 4) DC_VLOAD(T + 1);
            asm volatile("s_waitcnt lgkmcnt(0)" ::: "memory");
            const bf16x8 pb = __builtin_bit_cast(bf16x8, (u32x4){pkbf(S[2 * T][0], S[2 * T][1]), pkbf(S[2 * T][2], S[2 * T][3]), pkbf(S[2 * T + 1][0], S[2 * T + 1][1]), pkbf(S[2 * T + 1][2], S[2 * T + 1][3])});
#pragma unroll
            for (int vt = 0; vt < 8; ++vt) { const LAS unsigned char* vp = wreg + (4 * Q + (li >> 2)) * VP + (16 * vt + 4 * (li & 3)) * 2;
                const s16x4 lo = trd(vp), hi = trd(vp + 16 * VP); const bf16x8 vf = (bf16x8){lo[0], lo[1], lo[2], lo[3], hi[0], hi[1], hi[2], hi[3]};
                OT[vt] = __builtin_amdgcn_mfma_f32_16x16x32_bf16(vf, pb, OT[vt], 0, 0, 0); if ((vt & 3) == 3) __builtin_amdgcn_sched_barrier(0); }
            asm volatile("s_waitcnt lgkmcnt(0)" ::: "memory");
            __builtin_amdgcn_sched_barrier(0);
        }
#undef DC_KLOAD
#undef DC_LD
#undef DC_KF
#undef DC_KPARK
#undef DC_VLOAD
    }
    lrun += __shfl_xor(lrun, 16); lrun += __shfl_xor(lrun, 32);
    if (Q == 0) { const size_t o = (size_t)((s * NH + h) * 16 + li) * NSPLIT + g;
        __hip_atomic_store((gu32*)(a.ws + WS_DEC + PM_OFF) + o, __float_as_uint(mrun), RLX_AGENT); __hip_atomic_store((gu32*)(a.ws + WS_DEC + PL_OFF) + o, __float_as_uint(lrun), RLX_AGENT); }
    { const __amdgpu_buffer_rsrc_t rs = __builtin_amdgcn_make_buffer_rsrc(a.ws + WS_DEC + PO_OFF, 0, (int)PO_BYTES, 0x00020000);
      const unsigned off = (unsigned)((((((size_t)s * NSPLIT + g) * NH + h) * 16 + li) * 128 + 4 * Q) * 4);
#pragma unroll
      for (int vt = 0; vt < 8; ++vt) __builtin_amdgcn_raw_buffer_store_b128(__builtin_bit_cast(u32x4, OT[vt]), rs, off + 64 * vt, 0, 16); }
    asm volatile("s_waitcnt vmcnt(0)" ::: "memory");
    __syncthreads();
    if (tid == 0) (void)__hip_atomic_fetch_add(cnt + 64 * s, 1u, RLX_AGENT);
}
}
namespace th {
typedef short bf16x8 __attribute__((ext_vector_type(8)));
typedef float f32x4 __attribute__((ext_vector_type(4)));
typedef unsigned u32x4_t __attribute__((ext_vector_type(4)));
template <int K>
__device__ __forceinline__ void stream_gemm(LAS unsigned char* slab, const bf16* X, const bf16* W, int ld, int row0, int n0, int w, int lane, f32x4 (&acc)[2]) {
    constexpr int NG = K / 128, RP = 272; static_assert(NG * 128 == K, "K in groups of 128");
    const int r = lane >> 4, c = lane & 15, li = lane & 15, Q = lane >> 4;
    const GAS unsigned char* wb = (const GAS unsigned char*)(W + (size_t)(n0 + r) * ld) + 16 * c;
    const GAS unsigned char* xb = (const GAS unsigned char*)(X + (size_t)(row0 + r) * ld) + 16 * c;
    const size_t rs4 = (size_t)ld * 8;
    LAS unsigned char* wr = slab + r * RP + 16 * c;
    const LAS unsigned char* fa = slab + li * RP + 16 * Q;
    u32x4_t t[12];
    int g = w;
    if (g < NG) {
#pragma unroll
        for (int j = 0; j < 12; ++j) t[j] = *(const GAS u32x4_t*)((j < 4 ? wb + j * rs4 : xb + (j - 4) * rs4) + (size_t)g * 256);
    }
#pragma unroll 1
    for (; g < NG; g += 8) {
#pragma unroll
        for (int j = 0; j < 12; ++j) *(LAS u32x4_t*)(wr + 4 * j * RP) = t[j];
        if (g + 8 < NG) {
#pragma unroll
            for (int j = 0; j < 12; ++j) t[j] = *(const GAS u32x4_t*)((j < 4 ? wb + j * rs4 : xb + (j - 4) * rs4) + (size_t)(g + 8) * 256);
        }
        asm volatile("s_waitcnt lgkmcnt(0)" ::: "memory");
        bf16x8 af[4], b0[4], b1[4];
#pragma unroll
        for (int s = 0; s < 4; ++s) { af[s] = *(const LAS bf16x8*)(fa + 64 * s); b0[s] = *(const LAS bf16x8*)(fa + 16 * RP + 64 * s); b1[s] = *(const LAS bf16x8*)(fa + 32 * RP + 64 * s); }
#pragma unroll
        for (int s = 0; s < 4; ++s) { acc[0] = __builtin_amdgcn_mfma_f32_16x16x32_bf16(af[s], b0[s], acc[0], 0, 0, 0); acc[1] = __builtin_amdgcn_mfma_f32_16x16x32_bf16(af[s], b1[s], acc[1], 0, 0, 0); }
        asm volatile("s_waitcnt lgkmcnt(0)" ::: "memory");
    }
}
template <int K, int NACC, class Epi>
__device__ __forceinline__ void tile(LAS unsigned char* lds, const bf16* X1, const bf16* W1, const bf16* X2, const bf16* W2, int row0, int n0, const Epi& E, int ld = K) {
    int tid = threadIdx.x; asm volatile("" : "+v"(tid));
    const int lane = tid & 63, w = __builtin_amdgcn_readfirstlane(tid >> 6), li = lane & 15, Q = lane >> 4;
    f32x4 acc[NACC][2];
#pragma unroll
    for (int g = 0; g < NACC; ++g)
#pragma unroll
        for (int mt = 0; mt < 2; ++mt) acc[g][mt] = (f32x4){0.f, 0.f, 0.f, 0.f};
    LAS unsigned char* slab = lds + w * (48 * 272);
    stream_gemm<K>(slab, X1, W1, ld, row0, n0, w, lane, acc[0]);
    if constexpr (NACC == 2) stream_gemm<K>(slab, X2, W2, ld, row0, n0, w, lane, acc[1]);
    HG_LBAR();
    LAS float* P = (LAS float*)lds;
#pragma unroll
    for (int g = 0; g < NACC; ++g)
#pragma unroll
        for (int mt = 0; mt < 2; ++mt)
#pragma unroll
            for (int r = 0; r < 4; ++r) P[(w * NACC * 8 + g * 8 + mt * 4 + r) * 64 + lane] = acc[g][mt][r];
    HG_LBAR();
    const int mt = w >> 2, r0 = w & 3;
    float v[NACC];
#pragma unroll
    for (int g = 0; g < NACC; ++g) { float s = 0.f;
#pragma unroll
        for (int ww = 0; ww < 8; ++ww) s += P[(ww * NACC * 8 + g * 8 + mt * 4 + r0) * 64 + lane];
        v[g] = s; }
    E(row0 + 16 * mt + li, n0 + 4 * Q + r0, v[0], v[NACC - 1]);
    HG_LBAR();
}
}
constexpr int N_PHASES = 9;
#if 0
#define PROBE_PHASE_UNUSED -1
#endif
#define REP(k) for (int rp_ = 0; rp_ < ((PROBE_PHASE == (k)) ? 2 : 1); ++rp_)
#define PROBE_MUL(k) ((PROBE_PHASE == (k) || PROBE_PHASE == 29) ? 2 : 1)
#define REPBAR(k) do { if (PROBE_PHASE == (k) && rp_ == 0) GRID_BAR(); } while (0)
__global__ void __launch_bounds__(NWAVES * 64, 2) mk_fwd(Args args) {
    extern __shared__ __attribute__((aligned(16))) unsigned char lds[];
    Frame F;
    F.lds = (LAS unsigned char*)lds; F.MISC = (volatile LAS unsigned*)(F.lds + MISC_OFF);
    F.tid = threadIdx.x; F.lane = F.tid & 63; F.wave = __builtin_amdgcn_readfirstlane(F.tid >> 6);
    F.G = gridDim.x; { const int bx = blockIdx.x; F.vcu = (F.G % 8 == 0) ? (bx % 8) * (F.G / 8) + bx / 8 : bx; }
    unsigned char* ws = args.ws;
    F.ctl = (gu32*)(ws + WS_CTL);
    for (int u = F.tid; u < (LDS_BYTES - LDSCTL_OFF) / 4; u += NWAVES * 64) ((LAS unsigned*)(F.lds + LDSCTL_OFF))[u] = 0u;
    __syncthreads();
    const int lo = args.ph_lo, hi = args.ph_hi;
    XcdBarrier bar = xcd_barrier_post((unsigned*)(F.ctl + CW_BAR) + lo * XCD_BAR_WORDS, F.MISC + 8);
#define IN(k) (lo <= (k) && (k) < hi)
#define BOTH(k) (IN(k) && IN((k) + 1))
#define GRID_BAR() xcd_barrier(bar)
    if (IN(0)) REP(0) { p0_prologue(F, args); REPBAR(0); if (BOTH(0)) GRID_BAR(); }
    if (IN(1)) REP(1) {
        pg8::Gemm g{(const bf16*)(ws + WS_XN), (const bf16*)(ws + WS_WIN), MT, NIN, DM}; pg8::StaticOrder S; S.init(MT, NIN, F.G, (int)blockIdx.x);
        pg8::EpiInProj E{(bf16*)(ws + WS_U), (float*)(ws + WS_G), args.out + O_KP, args.out + O_VP, args.out + O_KS, args.out + O_VS, args.in[11], NIN, MP, MREAL, QSCALE};
        pg8::gemm_phase<pg8::EpiInProj, pg8::StaticOrder, true, true>(F.lds + RING_OFF, g, S, E);
        if (rp_ == 0) convert_late(F, args, F.ctl + CW_Q + 32);
        REPBAR(1); if (BOTH(1)) GRID_BAR();
    }
    if (PROBE_PHASE == 30) { for (int i = 0; i < 16; ++i) GRID_BAR(); }
    if (IN(2)) REP(2) {
        const float lam = da_lambda(args);
#define QPOP(word) ({ if (F.tid == 0) F.MISC[0] = __hip_atomic_fetch_add(F.ctl + (word), 1u, RLX_AGENT); __syncthreads(); const int u_ = __builtin_amdgcn_readfirstlane((int)F.MISC[0]); __syncthreads(); u_; })
        const bool roleA = (((blockIdx.x >> 3) & 1) == 0) || F.G < 128;
        if ((args.p2mask & 1) && roleA) for (;;) { const int u = QPOP(CW_Q + 256 * rp_); if (u >= PB * NH * PROBE_MUL(20)) break; hg::prompt_unit(F.lds + RING_OFF, args, (u % (PB * NH)) / NH, u % NH); }
        if ((args.p2mask & 8) && roleA) for (;;) { const int u = QPOP(CW_Q + 192 + 256 * rp_); if (u >= SB * NH) break; hg::sample_unit(F.lds + RING_OFF, args, u / NH, u % NH); }
        if ((args.p2mask & 2) && ((blockIdx.x >> 3) & 1)) for (;;) { const int u = QPOP(CW_Q + 64 + 256 * rp_); if (u >= SB * dc::NSPLIT * PROBE_MUL(21)) break; const int uu = u % (SB * dc::NSPLIT), rr = u / (SB * dc::NSPLIT);
                   dc::unit(F.lds + RING_OFF, args, F.ctl + CW_DCNT + 512 * (rp_ + rr), uu / dc::NSPLIT, uu % dc::NSPLIT, lam); }
        if (args.p2mask & 4) for (;;) { const int u = QPOP(CW_Q + 128 + 256 * rp_); if (u >= PB * DAH * 16 * PROBE_MUL(22)) break; const int uu = u % (PB * DAH * 16), qb = 15 - (uu >> 5), bh = uu & 31; at::prompt_unit(F.lds + RING_OFF, args, bh / DAH, bh % DAH, qb, lam); }
        if (args.p2mask & 2) for (;;) { const int u = QPOP(CW_Q + 64 + 256 * rp_); if (u >= SB * dc::NSPLIT * PROBE_MUL(21)) break; const int uu = u % (SB * dc::NSPLIT), rr = u / (SB * dc::NSPLIT);
                   dc::unit(F.lds + RING_OFF, args, F.ctl + CW_DCNT + 512 * (rp_ + rr), uu / dc::NSPLIT, uu % dc::NSPLIT, lam); }
        if (args.p2mask & 2) for (;;) { const int u = QPOP(CW_Q + 224 + 256 * rp_); if (u >= SB * NH * PROBE_MUL(21)) break; const int uu = u % (SB * NH), rr = u / (SB * NH);
                   dc::combine_task(F.lds + RING_OFF, args, F.ctl + CW_DCNT + 512 * (rp_ + rr), uu / NH, uu % NH, lam); }
#undef QPOP
        REPBAR(2); if (BOTH(2)) GRID_BAR();
    }
    if (IN(3)) REP(3) {
        { pg8::Gemm g{(const bf16*)(ws + WS_OHG), (const bf16*)(ws + WS_WBH), MP, DM, OPITCH}; pg8::StaticOrder S; S.init(MP, DM, F.G, (int)blockIdx.x, 4);
          pg8::EpiBranchCat E{(const bf16*)(ws + WS_U) + C_GHG, (const bf16*)(ws + WS_U) + C_GDA, NIN, (bf16*)(ws + WS_MIX)};
          pg8::gemm_phase<pg8::EpiBranchCat, pg8::StaticOrder, true, true>(F.lds + RING_OFF, g, S, E); }
        for (int tn = (int)blockIdx.x; tn < 2 * (DM / 16); tn += F.G) {
            const bf16* Ub = (const bf16*)(ws + WS_U); bf16* MIX = (bf16*)(ws + WS_MIX);
            auto E = [=](int tok, int n, float a, float b) { const size_t row = (size_t)(MP + tok);
                MIX[row * DM + n] = (bf16)f2bf(bf2f(Ub[row * NIN + C_GHG + n]) * a + bf2f(Ub[row * NIN + C_GDA + n]) * b); };
            th::tile<1024, 2>(F.lds + RING_OFF, (const bf16*)(ws + WS_OHG) + (size_t)MP * OPITCH, (const bf16*)(ws + WS_WBH), (const bf16*)(ws + WS_ODA) + (size_t)MP * OPITCH, (const bf16*)(ws + WS_WBD), 32 * (tn & 1), 16 * (tn >> 1), E, OPITCH);
        }
        REPBAR(3); if (BOTH(3)) GRID_BAR();
    }
    if (IN(4)) REP(4) {
        pg8::Gemm g{(const bf16*)(ws + WS_MIX), (const bf16*)(ws + WS_WOUT), MP, DM, DM}; pg8::StaticOrder S; S.init(MP, DM, F.G, (int)blockIdx.x, 4);
        pg8::EpiBf16Plain E{(bf16*)(ws + WS_Y1), DM};
        pg8::gemm_phase<pg8::EpiBf16Plain, pg8::StaticOrder, true, true>(F.lds + RING_OFF, g, S, E);
        for (int tn = (int)blockIdx.x; tn < 2 * (DM / 16); tn += F.G) {
            bf16* Y = (bf16*)(ws + WS_Y1);
            auto Et = [=](int tok, int n, float a, float) { Y[(size_t)(MP + tok) * DM + n] = (bf16)f2bf(a); };
            th::tile<DM, 1>(F.lds + RING_OFF, (const bf16*)(ws + WS_MIX) + (size_t)MP * DM, (const bf16*)(ws + WS_WOUT), nullptr, nullptr, 32 * (tn & 1), 16 * (tn >> 1), Et);
        }
        REPBAR(4); if (BOTH(4)) GRID_BAR();
    }
    if (IN(5)) REP(5) { row_pass1(F, args); REPBAR(5); if (BOTH(5)) GRID_BAR(); }
    if (IN(6)) REP(6) {
        pg8::Gemm g{(const bf16*)(ws + WS_XN2), (const bf16*)(ws + WS_WUP), MT, NIN, DM}; pg8::StaticOrder S; S.init(MT, NIN, F.G, (int)blockIdx.x);
        pg8::EpiSwiGLU E{(bf16*)(ws + WS_HID), DFF};
        pg8::gemm_phase<pg8::EpiSwiGLU, pg8::StaticOrder, true, true>(F.lds + RING_OFF, g, S, E);
        if (rp_ == 0) convert_dn(F, args, F.ctl + CW_Q + 36);
        REPBAR(6); if (BOTH(6)) GRID_BAR();
    }
    if (IN(7)) REP(7) {
        pg8::Gemm g{(const bf16*)(ws + WS_HID), (const bf16*)(ws + WS_WDN), MP, DM, DFF}; pg8::StaticOrder S; S.init(MP, DM, F.G, (int)blockIdx.x, 4);
        pg8::EpiBf16Plain E{(bf16*)(ws + WS_Y2), DM};
        pg8::gemm_phase<pg8::EpiBf16Plain, pg8::StaticOrder, true, true>(F.lds + RING_OFF, g, S, E);
        for (int tn = (int)blockIdx.x; tn < 2 * (DM / 16); tn += F.G) {
            bf16* Y = (bf16*)(ws + WS_Y2);
            auto Et = [=](int tok, int n, float a, float) { Y[(size_t)(MP + tok) * DM + n] = (bf16)f2bf(a); };
            th::tile<DFF, 1>(F.lds + RING_OFF, (const bf16*)(ws + WS_HID) + (size_t)MP * DFF, (const bf16*)(ws + WS_WDN), nullptr, nullptr, 32 * (tn & 1), 16 * (tn >> 1), Et);
        }
        REPBAR(7); if (BOTH(7)) GRID_BAR();
    }
    if (IN(8)) REP(8) { row_pass2(F, args); REPBAR(8); }
#undef IN
#undef BOTH
#undef GRID_BAR
}
extern "C" void kernel_launch(void* const* d_in, const int* in_sizes, int n_in, void* d_out, int out_size, void* d_ws, size_t ws_size, hipStream_t stream) {
    static int grid = 0;
    if (grid == 0) {
        if (n_in != 24 || in_sizes[0] != MP * DM || (size_t)out_size != O_END || ws_size < WS_END) { fprintf(stderr, "kernel_launch: unexpected shapes (n_in %d, in0 %d, out %d, ws %zu); nothing launched\n", n_in, n_in > 0 ? in_sizes[0] : -1, out_size, ws_size); grid = -1; return; }
        int dev = 0, cus = 0, per_cu = 0;
        if (hipGetDevice(&dev) != hipSuccess || hipDeviceGetAttribute(&cus, hipDeviceAttributeMultiprocessorCount, dev) != hipSuccess) { grid = -1; return; }
        if (hipFuncSetAttribute((const void*)mk_fwd, hipFuncAttributeMaxDynamicSharedMemorySize, LDS_BYTES) != hipSuccess) { fprintf(stderr, "kernel_launch: hipFuncSetAttribute failed\n"); grid = -1; return; }
        if (hipOccupancyMaxActiveBlocksPerMultiprocessor(&per_cu, (const void*)mk_fwd, NWAVES * 64, LDS_BYTES) != hipSuccess || per_cu < 1) fprintf(stderr, "kernel_launch: note: occupancy query reports %d\n", per_cu);
        (void)hipGetLastError();
        grid = cus;
    }
    if (grid < 0) return;
    (void)hipMemsetAsync((char*)d_ws + WS_CTL, 0, CTL_ZERO_BYTES, stream);
    Args a{};
    for (int i = 0; i < 24; ++i) a.in[i] = (const float*)d_in[i];
    a.page_table = (const int*)d_in[5]; a.out = (float*)d_out; a.ws = (unsigned char*)d_ws;
    a.ph_lo = 0; a.ph_hi = N_PHASES; a.p2mask = 15;
    hipLaunchKernelGGL(mk_fwd, dim3(grid), dim3(NWAVES * 64), LDS_BYTES, stream, a);
#if defined(PROBE_TWICE)
    (void)hipMemsetAsync((char*)d_ws + WS_CTL, 0, CTL_ZERO_BYTES, stream);
    hipLaunchKernelGGL(mk_fwd, dim3(grid), dim3(NWAVES * 64), LDS_BYTES, stream, a);
#endif
#if defined(PROBE_RELAUNCH)
    (void)hipMemsetAsync((char*)d_ws + WS_CTL + 64 * 4, 0, (4096 - 64) * 4, stream);
    a.ph_lo = PROBE_RELAUNCH; a.ph_hi = PROBE_RELAUNCH + 1;
#if defined(PROBE_P2MASK)
    a.p2mask = PROBE_P2MASK;
#endif
    hipLaunchKernelGGL(mk_fwd, dim3(grid), dim3(NWAVES * 64), LDS_BYTES, stream, a);
#endif
}
```

```cpp
#include <hip/hip_runtime.h>
#include <cstdio>
#include <cstdint>
#define PROBE_PHASE -1
namespace pg8 {
#define PG8_LAS __attribute__((address_space(3)))
typedef unsigned short bf16_t;
typedef short bf16x8 __attribute__((ext_vector_type(8)));
typedef float f32x4 __attribute__((ext_vector_type(4)));
typedef unsigned u32x4 __attribute__((ext_vector_type(4)));
constexpr int BM = 256, BK = 64, HALF = 128, HTB = HALF * BK * 2  , STAGE_BYTES = 8 * HTB, NXCD = 8, WGM = 8;

__host__ __device__ __forceinline__ int lds_byte(int r, int c) { const int st = (r >> 4) * 2 + (c >> 5), rr = r & 15, cc = c & 31, ob = rr * 64 + cc * 2; return st * 1024 + (ob ^ (((ob >> 9) & 1) << 5)); }
__host__ __device__ __forceinline__ void stage_rc(int b, int& R, int& C) { const int st = b / 1024, sb = b % 1024, swz = sb ^ (((sb >> 9) & 1) << 5); R = (st >> 1) * 16 + swz / 64; C = (st & 1) * 32 + (swz % 64) / 2; }
__host__ __device__ __forceinline__ int perm32(int rho) { const int n = rho >> 4, i = rho & 15; return 8 * (i >> 2) + 4 * n + (i & 3); }

struct Unit { int pm, pn; };
struct Gemm { const bf16_t* A; const bf16_t* Bt; int M, N, K; };

struct StaticOrder {
    int nM, nN, nwg, G, c, wgm;
    __host__ __device__ void init(int M, int N, int G_, int c_, int wgm_ = WGM) { nM = M / BM; nN = N / BM; nwg = nM * nN; G = G_; c = c_; wgm = wgm_; }
    __host__ __device__ bool next(int i, Unit& u) const {
        const long L = (long)i * G + c; if (L >= nwg) return false;
        int wgid = (int)L; { const int q = nwg / NXCD, r = nwg % NXCD, xcd = wgid % NXCD, off = wgid / NXCD; wgid = (xcd < r ? xcd * (q + 1) : r * (q + 1) + (xcd - r) * q) + off; }
        const int nig = wgm * nN, gid = wgid / nig, fm = gid * wgm, gsz = (nM - fm) < wgm ? (nM - fm) : wgm;
        u.pm = fm + ((wgid % nig) % gsz); u.pn = (wgid % nig) / gsz; return true;
    }
    __device__ __forceinline__ void a_ready(const Unit&) const {}
    __device__ __forceinline__ void done(const Unit&) const {}
};

__device__ __forceinline__ unsigned cvt_pk_bf16(float lo, float hi) { unsigned r; asm volatile("v_cvt_pk_bf16_f32 %0, %1, %2" : "=v"(r) : "v"(lo), "v"(hi)); return r; }
__device__ __forceinline__ float bf2f(unsigned short h) { return __uint_as_float((unsigned)h << 16); }
__device__ __forceinline__ float sigmoidf_(float x) { return __builtin_amdgcn_rcpf(1.0f + __expf(-x)); }
__device__ __forceinline__ u32x4 pack8(const f32x4 a, const f32x4 b) { u32x4 w; w.x = cvt_pk_bf16(a[0], a[1]); w.y = cvt_pk_bf16(a[2], a[3]); w.z = cvt_pk_bf16(b[0], b[1]); w.w = cvt_pk_bf16(b[2], b[3]); return w; }
__device__ __forceinline__ void unpack8(const u32x4 w, f32x4& a, f32x4& b) {
    a[0] = __uint_as_float(w.x << 16); a[1] = __uint_as_float(w.x & 0xffff0000u); a[2] = __uint_as_float(w.y << 16); a[3] = __uint_as_float(w.y & 0xffff0000u);
    b[0] = __uint_as_float(w.z << 16); b[1] = __uint_as_float(w.z & 0xffff0000u); b[2] = __uint_as_float(w.w << 16); b[3] = __uint_as_float(w.w & 0xffff0000u); }

struct EpiInProj {
    static constexpr bool PERM = true, AFTER_DRAIN = false, HAS_MID = false;
    bf16_t* U; float* G; float* out_kp; float* out_vp; float* out_ks; float* out_vs; const float* lbl; int n_in, mp, mreal; float qscale;
    __device__ __forceinline__ void operator()(const f32x4 (&acc)[2][2][4][2], const Unit& u, int wr, int wc, int fr, int fq) const {
        const int pn = u.pn, row0 = u.pm * BM + wr * 64 + fr, colb = pn * BM + wc * 32 + 8 * fq;
        const int grp = pn >> 2;
        if (grp == 1) {
            float lb[2][8];
#pragma unroll
            for (int bj = 0; bj < 2; ++bj)
#pragma unroll
                for (int e = 0; e < 8; ++e) { const int c = colb + bj * HALF + e - 1024; const float l0 = lbl[c], l1 = lbl[1024 + c]; lb[bj][e] = 1.0f / (1.0f + expf(l1 - l0)); }
#pragma unroll
            for (int ai = 0; ai < 2; ++ai)
#pragma unroll
                for (int m = 0; m < 4; ++m) { const size_t row = (size_t)(row0 + ai * HALF + m * 16);
#pragma unroll
                    for (int bj = 0; bj < 2; ++bj) { f32x4 v0 = acc[ai][bj][m][0], v1 = acc[ai][bj][m][1], k0, k1;
#pragma unroll
                        for (int e = 0; e < 4; ++e) { const float s0 = __builtin_amdgcn_rcpf(1.0f + __expf(-v0[e])), s1 = __builtin_amdgcn_rcpf(1.0f + __expf(-v1[e])), a0 = 1.0f - lb[bj][e], a1 = 1.0f - lb[bj][4 + e];
                            v0[e] = __logf(lb[bj][e] + a0 * s0); v1[e] = __logf(lb[bj][4 + e] + a1 * s1); k0[e] = a0 * (1.0f - s0); k1[e] = a1 * (1.0f - s1); }
                        float* gp = G + row * 1024 + (colb + bj * HALF - 1024); *(f32x4*)gp = v0; *(f32x4*)(gp + 4) = v1;
                        *(u32x4*)(U + row * n_in + colb + bj * HALF) = pack8(k0, k1); } }
            return;
        }
#pragma unroll
        for (int ai = 0; ai < 2; ++ai)
#pragma unroll
            for (int m = 0; m < 4; ++m) { const int row = row0 + ai * HALF + m * 16;
#pragma unroll
                for (int bj = 0; bj < 2; ++bj) { f32x4 v0 = acc[ai][bj][m][0], v1 = acc[ai][bj][m][1]; const int col = colb + bj * HALF;
                    if (grp == 5 || grp == 6) {
                        float* o = nullptr;
                        if (row < mp) o = (grp == 5 ? out_kp : out_vp) + (size_t)row * 1024; else if (row < mreal) o = (grp == 5 ? out_ks : out_vs) + (size_t)(row - mp) * 1024;
                        if (o) { o += col - (grp == 5 ? 5120 : 6144); *(f32x4*)o = v0; *(f32x4*)(o + 4) = v1; }
                    } else if (grp == 3) {
#pragma unroll
                        for (int e = 0; e < 4; ++e) { v0[e] = v0[e] * sigmoidf_(v0[e]); v1[e] = v1[e] * sigmoidf_(v1[e]); }
                    } else if (grp == 4) { v0 = v0 * qscale; v1 = v1 * qscale; }
                    else if (grp >= 7) {
#pragma unroll
                        for (int e = 0; e < 4; ++e) { v0[e] = sigmoidf_(v0[e]); v1[e] = sigmoidf_(v1[e]); }
                    }
                    *(u32x4*)(U + (size_t)row * n_in + col) = pack8(v0, v1); } }
    }
};
struct EpiBf16Plain {
    static constexpr bool PERM = true, AFTER_DRAIN = false, HAS_MID = false;
    bf16_t* Y; int ldc;
    __device__ __forceinline__ void operator()(const f32x4 (&acc)[2][2][4][2], const Unit& u, int wr, int wc, int fr, int fq) const {
        const int row0 = u.pm * BM + wr * 64 + fr, colb = u.pn * BM + wc * 32 + 8 * fq;
#pragma unroll
        for (int ai = 0; ai < 2; ++ai)
#pragma unroll
            for (int m = 0; m < 4; ++m) { const size_t row = (size_t)(row0 + ai * HALF + m * 16);
#pragma unroll
                for (int bj = 0; bj < 2; ++bj) *(u32x4*)(Y + row * ldc + colb + bj * HALF) = pack8(acc[ai][bj][m][0], acc[ai][bj][m][1]); }
    }
};
struct EpiSwiGLU {
    static constexpr bool PERM = true, AFTER_DRAIN = false, HAS_MID = false;
    bf16_t* HID; int ldh;
    __device__ __forceinline__ void operator()(const f32x4 (&acc)[2][2][4][2], const Unit& u, int wr, int wc, int fr, int fq) const {
        const int row0 = u.pm * BM + wr * 64 + fr, col = u.pn * HALF + wc * 32 + 8 * fq;
#pragma unroll
        for (int ai = 0; ai < 2; ++ai)
#pragma unroll
            for (int m = 0; m < 4; ++m) { const size_t row = (size_t)(row0 + ai * HALF + m * 16);
                f32x4 a = acc[ai][0][m][0], b = acc[ai][0][m][1]; const f32x4 ua = acc[ai][1][m][0], ub = acc[ai][1][m][1];
#pragma unroll
                for (int e = 0; e < 4; ++e) { a[e] = a[e] * sigmoidf_(a[e]) * ua[e]; b[e] = b[e] * sigmoidf_(b[e]) * ub[e]; }
                *(u32x4*)(HID + row * ldh + col) = pack8(a, b); }
    }
};

struct EpiBranchCat {
    static constexpr bool PERM = true, AFTER_DRAIN = false, HAS_MID = true;
    const bf16_t* SGH; const bf16_t* SGD; int ldsg; bf16_t* MIX;
    __device__ __forceinline__ void mid(f32x4 (&acc)[2][2][4][2], const Unit& u, int wr, int wc, int fr, int fq) const {
        int opq = 0; asm volatile("" : "+v"(opq));
        const int row0 = u.pm * BM + wr * 64 + fr + opq, colb = u.pn * BM + wc * 32 + 8 * fq;
#define SC2_(A, lo, hw, dw) A[lo] *= __uint_as_float((hw) << 16) * __builtin_amdgcn_rcpf(fmaxf(__uint_as_float((dw) << 16), 1e-20f)); A[lo + 1] *= __uint_as_float((hw) & 0xffff0000u) * __builtin_amdgcn_rcpf(fmaxf(__uint_as_float((dw) & 0xffff0000u), 1e-20f))
#pragma unroll
        for (int ai = 0; ai < 2; ++ai) {
            u32x4 hw[4][2], dw[4][2];
#pragma unroll
            for (int m = 0; m < 4; ++m) { const size_t row = (size_t)(row0 + ai * HALF + m * 16);
#pragma unroll
                for (int bj = 0; bj < 2; ++bj) { const int col = colb + bj * HALF; hw[m][bj] = *(const u32x4*)(SGH + row * ldsg + col); dw[m][bj] = *(const u32x4*)(SGD + row * ldsg + col); } }
#pragma unroll
            for (int m = 0; m < 4; ++m)
#pragma unroll
                for (int bj = 0; bj < 2; ++bj) { SC2_(acc[ai][bj][m][0], 0, hw[m][bj].x, dw[m][bj].x); SC2_(acc[ai][bj][m][0], 2, hw[m][bj].y, dw[m][bj].y); SC2_(acc[ai][bj][m][1], 0, hw[m][bj].z, dw[m][bj].z); SC2_(acc[ai][bj][m][1], 2, hw[m][bj].w, dw[m][bj].w); }
            asm volatile("" ::: "memory"); }
#undef SC2_
    }
    __device__ __forceinline__ void operator()(const f32x4 (&acc)[2][2][4][2], const Unit& u, int wr, int wc, int fr, int fq) const {
        const int row0 = u.pm * BM + wr * 64 + fr, colb = u.pn * BM + wc * 32 + 8 * fq;
#pragma unroll
        for (int ai = 0; ai < 2; ++ai)
#pragma unroll
            for (int m = 0; m < 4; ++m) { const size_t row = (size_t)(row0 + ai * HALF + m * 16);
#pragma unroll
                for (int bj = 0; bj < 2; ++bj) { const int col = colb + bj * HALF; f32x4 d0, d1; unpack8(*(const u32x4*)(SGD + row * ldsg + col), d0, d1);
#pragma unroll
                    for (int e = 0; e < 4; ++e) { d0[e] = fmaxf(d0[e], 1e-20f); d1[e] = fmaxf(d1[e], 1e-20f); }
                    *(u32x4*)(MIX + row * 2048 + col) = pack8(acc[ai][bj][m][0] * d0, acc[ai][bj][m][1] * d1); } }
    }
};
template <class Epi, class Sched, bool ALIGN_EPI = false, bool SP2 = false>
__device__ __forceinline__ void gemm_phase(PG8_LAS unsigned char* lds, const Gemm g, const Sched& S, const Epi& E) {
    const int tid = threadIdx.x, wid = __builtin_amdgcn_readfirstlane(tid >> 6), lane = tid & 63, wr = wid >> 2, wc = wid & 3, fr = lane & 15, fq = lane >> 4;
    const int K = g.K, nt = K / BK;
    unsigned voffA[2], voffB[2];
#pragma unroll
    for (int i = 0; i < 2; ++i) { int R, C; stage_rc(tid * 16 + i * 8192, R, C); const int Rb = Epi::PERM ? ((R & ~31) + perm32(R & 31)) : R;
        voffA[i] = (unsigned)(R * K + C) * 2u; voffB[i] = (unsigned)(Rb * K + C) * 2u; }
    const size_t kstep = (size_t)(BK * 2);
    const size_t hstep = (size_t)HALF * K * 2;
    const size_t tstep = 2 * hstep;
    const unsigned ldsw = (unsigned)wid * 1024u;
    const int aoff = lds_byte(wr * 64 + fr, fq * 8), boff = lds_byte(wc * 32 + fr, fq * 8);
#define PG8_SA(b, h) (((b) * 2 + (h)) * HTB)
#define PG8_SB(b, h) ((4 + (b) * 2 + (h)) * HTB)
#define PG8_STAGE(bufoff, gbase, voff) do { _Pragma("unroll") for (int _i = 0; _i < 2; ++_i) \
        __builtin_amdgcn_global_load_lds((const unsigned*)((const char*)(gbase) + (voff)[_i]), (PG8_LAS unsigned*)(lds + (bufoff) + ldsw + _i * 8192), 16, 0, 0); } while (0)
#define PG8_LDA(dst, b, h) do { _Pragma("unroll") for (int m = 0; m < 4; ++m) _Pragma("unroll") for (int k = 0; k < 2; ++k) dst[m][k] = *(const PG8_LAS bf16x8*)(lds + PG8_SA(b, h) + aoff + m * 2048 + k * 1024); } while (0)
#define PG8_LDB(dst, b, h) do { _Pragma("unroll") for (int n = 0; n < 2; ++n) _Pragma("unroll") for (int k = 0; k < 2; ++k) dst[n][k] = *(const PG8_LAS bf16x8*)(lds + PG8_SB(b, h) + boff + n * 2048 + k * 1024); } while (0)
#define PG8_MMA(ai, bj, At, Bt) do { __builtin_amdgcn_s_setprio(1); _Pragma("unroll") for (int m = 0; m < 4; ++m) _Pragma("unroll") for (int n = 0; n < 2; ++n) _Pragma("unroll") for (int k = 0; k < 2; ++k) \
        acc[ai][bj][m][n] = __builtin_amdgcn_mfma_f32_16x16x32_bf16(Bt[n][k], At[m][k], acc[ai][bj][m][n], 0, 0, 0); __builtin_amdgcn_s_setprio(0); } while (0)
#define PG8_WAIT_V(n) asm volatile("s_waitcnt vmcnt(" #n ")" ::: "memory")
#define PG8_WAIT_L(n) asm volatile("s_waitcnt lgkmcnt(" #n ")" ::: "memory")
#define PG8_BAR __builtin_amdgcn_s_barrier()
#define PG8_SCHED __builtin_amdgcn_sched_barrier(0)
    Unit cur, nxt; int ui = 0;
    if (!S.next(0, cur)) return;
    f32x4 acc[2][2][4][2];
#pragma unroll
    for (int a = 0; a < 2; ++a)
#pragma unroll
        for (int b = 0; b < 2; ++b)
#pragma unroll
            for (int m = 0; m < 4; ++m)
#pragma unroll
                for (int n = 0; n < 2; ++n) acc[a][b][m][n] = (f32x4){0.f, 0.f, 0.f, 0.f};
    bf16x8 At[4][2], B0[2][2], B1[2][2];
    const char* cA = (const char*)g.A + (size_t)cur.pm * tstep; const char* cB = (const char*)g.Bt + (size_t)cur.pn * tstep;
    S.a_ready(cur);
    if constexpr (SP2) {
        PG8_STAGE(PG8_SB(0, 0), cB, voffB); PG8_STAGE(PG8_SB(0, 1), cB + hstep, voffB); PG8_STAGE(PG8_SA(0, 0), cA, voffA); PG8_STAGE(PG8_SA(0, 1), cA + hstep, voffA);
        if (wr == 1) PG8_BAR;
        PG8_WAIT_V(2); PG8_BAR;
        PG8_STAGE(PG8_SB(1, 0), cB + kstep, voffB); PG8_STAGE(PG8_SA(1, 0), cA + kstep, voffA); PG8_STAGE(PG8_SB(1, 1), cB + hstep + kstep, voffB);
        PG8_WAIT_V(6); PG8_BAR;
    } else {
        PG8_STAGE(PG8_SB(0, 0), cB, voffB); PG8_STAGE(PG8_SA(0, 0), cA, voffA); PG8_STAGE(PG8_SB(0, 1), cB + hstep, voffB); PG8_STAGE(PG8_SA(0, 1), cA + hstep, voffA);
        if (wr == 1) PG8_BAR;
        PG8_WAIT_V(4); PG8_BAR;
        PG8_STAGE(PG8_SB(1, 0), cB + kstep, voffB); PG8_STAGE(PG8_SA(1, 0), cA + kstep, voffA); PG8_STAGE(PG8_SB(1, 1), cB + hstep + kstep, voffB);
        PG8_WAIT_V(6); PG8_BAR;
    }
    for (;;) {
        const bool has_next = S.next(ui + 1, nxt);
        const char* nA = has_next ? (const char*)g.A + (size_t)nxt.pm * tstep : cA; const char* nB = has_next ? (const char*)g.Bt + (size_t)nxt.pn * tstep : cB;
        for (int t = 0; t < nt; t += 2) {
            const bool last = (t == nt - 2);
            const char* a1 = cA + (size_t)(t + 1) * kstep;
            const char* a2 = last ? nA : cA + (size_t)(t + 2) * kstep; const char* b2 = last ? nB : cB + (size_t)(t + 2) * kstep;
            const char* a3 = a2 + kstep; const char* b3 = b2 + kstep;
            if (last && has_next) S.a_ready(nxt);
            if constexpr (Epi::HAS_MID) { if (t == (nt >> 1)) E.mid(acc, cur, wr, wc, fr, fq); }
            if constexpr (SP2) {
            PG8_LDB(B0, 0, 0); PG8_LDB(B1, 0, 1); PG8_SCHED; PG8_LDA(At, 0, 0); PG8_STAGE(PG8_SA(1, 1), a1 + hstep, voffA);
            PG8_WAIT_V(8); PG8_WAIT_L(0); PG8_BAR; PG8_MMA(0, 0, At, B0); PG8_MMA(0, 1, At, B1); PG8_BAR; PG8_SCHED;
            PG8_LDA(At, 0, 1); PG8_STAGE(PG8_SB(0, 0), b2, voffB); PG8_STAGE(PG8_SB(0, 1), b2 + hstep, voffB); PG8_STAGE(PG8_SA(0, 0), a2, voffA);
            PG8_WAIT_V(8); PG8_WAIT_L(0); PG8_BAR; PG8_MMA(1, 0, At, B0); PG8_MMA(1, 1, At, B1); PG8_BAR; PG8_SCHED;
            PG8_LDB(B0, 1, 0); PG8_LDB(B1, 1, 1); PG8_SCHED; PG8_LDA(At, 1, 0); PG8_STAGE(PG8_SA(0, 1), a2 + hstep, voffA);
            PG8_WAIT_V(8); PG8_WAIT_L(0); PG8_BAR; PG8_MMA(0, 0, At, B0); PG8_MMA(0, 1, At, B1); PG8_BAR; PG8_SCHED;
            PG8_LDA(At, 1, 1); PG8_STAGE(PG8_SB(1, 0), b3, voffB); PG8_STAGE(PG8_SB(1, 1), b3 + hstep, voffB); PG8_STAGE(PG8_SA(1, 0), a3, voffA);
            PG8_WAIT_V(8); PG8_WAIT_L(0); PG8_BAR; PG8_MMA(1, 0, At, B0); PG8_MMA(1, 1, At, B1); PG8_BAR; PG8_SCHED;
            } else {
            PG8_LDB(B0, 0, 0); PG8_SCHED; PG8_LDA(At, 0, 0); PG8_STAGE(PG8_SA(1, 1), a1 + hstep, voffA);
            PG8_WAIT_L(8); PG8_BAR; PG8_WAIT_L(0); PG8_MMA(0, 0, At, B0); PG8_BAR; PG8_SCHED;
            PG8_LDB(B1, 0, 1); PG8_STAGE(PG8_SB(0, 0), b2, voffB);
            PG8_BAR; PG8_WAIT_L(0); PG8_MMA(0, 1, At, B1); PG8_BAR;
            PG8_LDA(At, 0, 1); PG8_STAGE(PG8_SA(0, 0), a2, voffA);
            PG8_BAR; PG8_WAIT_L(0); PG8_MMA(1, 0, At, B0); PG8_BAR; PG8_SCHED;
            PG8_STAGE(PG8_SB(0, 1), b2 + hstep, voffB);
            PG8_WAIT_V(6); PG8_BAR; PG8_MMA(1, 1, At, B1); PG8_BAR;
            PG8_LDB(B0, 1, 0); PG8_SCHED; PG8_LDA(At, 1, 0); PG8_STAGE(PG8_SA(0, 1), a2 + hstep, voffA);
            PG8_WAIT_L(8); PG8_BAR; PG8_WAIT_L(0); PG8_MMA(0, 0, At, B0); PG8_BAR; PG8_SCHED;
            PG8_LDB(B1, 1, 1); PG8_STAGE(PG8_SB(1, 0), b3, voffB);
            PG8_BAR; PG8_WAIT_L(0); PG8_MMA(0, 1, At, B1); PG8_BAR;
            PG8_LDA(At, 1, 1); PG8_STAGE(PG8_SA(1, 0), a3, voffA);
            PG8_BAR; PG8_WAIT_L(0); PG8_MMA(1, 0, At, B0); PG8_BAR; PG8_SCHED;
            PG8_STAGE(PG8_SB(1, 1), b3 + hstep, voffB);
            PG8_WAIT_V(6); PG8_BAR; PG8_MMA(1, 1, At, B1); PG8_BAR;
            }
        }
        if constexpr (ALIGN_EPI) { if (wr == 0) PG8_BAR; }
        if constexpr (!Epi::AFTER_DRAIN) { E(acc, cur, wr, wc, fr, fq); S.done(cur); }
        if (!has_next) break;
#pragma unroll
        for (int a = 0; a < 2; ++a)
#pragma unroll
            for (int b = 0; b < 2; ++b)
#pragma unroll
                for (int m = 0; m < 4; ++m)
#pragma unroll
                    for (int n = 0; n < 2; ++n) acc[a][b][m][n] = (f32x4){0.f, 0.f, 0.f, 0.f};
        cur = nxt; cA = nA; cB = nB; ++ui;
        if constexpr (ALIGN_EPI) { if (wr == 1) PG8_BAR; }
    }
    PG8_WAIT_V(0);
    if constexpr (!ALIGN_EPI) { if (wr == 0) PG8_BAR; }
    PG8_BAR;
    if constexpr (Epi::AFTER_DRAIN) { E.fused(acc, cur, wr, wc, fr, fq, lds, wid, lane); S.done(cur); }
#undef PG8_SA
#undef PG8_SB
#undef PG8_STAGE
#undef PG8_LDA
#undef PG8_LDB
#undef PG8_MMA
#undef PG8_WAIT_V
#undef PG8_WAIT_L
#undef PG8_BAR
#undef PG8_SCHED
}
}
#define GAS __attribute__((address_space(1)))
#define LAS __attribute__((address_space(3)))
typedef unsigned short bf16;
typedef unsigned v4u __attribute__((ext_vector_type(4)));
typedef float f32x4 __attribute__((ext_vector_type(4)));
typedef short bf16x8 __attribute__((ext_vector_type(8)));
typedef GAS unsigned gu32;
typedef GAS unsigned long long gu64;
#define RLX_AGENT __ATOMIC_RELAXED, __HIP_MEMORY_SCOPE_AGENT
#define LDS_WAIT() asm volatile("s_waitcnt lgkmcnt(0)" ::: "memory")
#define VM_WAIT() asm volatile("s_waitcnt vmcnt(0)" ::: "memory")
__device__ __forceinline__ unsigned long long rt() { return __builtin_amdgcn_s_memrealtime(); }
__device__ __forceinline__ unsigned f2bf(float f) { unsigned u = __builtin_bit_cast(unsigned, f); return (u + 0x7fffu + ((u >> 16) & 1u)) >> 16; }
__device__ __forceinline__ unsigned pk2(float lo, float hi) { return f2bf(lo) | (f2bf(hi) << 16); }
#define XB_TMO      128
#define XB_XCNT(j)  (256  + 64 * (j))
#define XB_XSUB(j)  (1280 + 64 * (j))
#define XB_XGEN(j)  (2304 + 64 * (j))
#define XB_TOP      3328
#define XB_TOPGEN   3392
#define XCD_BAR_WORDS 3456
#define XB_SPIN_CAP (1u << 18)

__device__ __forceinline__ unsigned xb_ld(unsigned* p)              { return __hip_atomic_load(p, __ATOMIC_RELAXED, __HIP_MEMORY_SCOPE_AGENT); }
__device__ __forceinline__ unsigned xb_add(unsigned* p, unsigned v) { return __hip_atomic_fetch_add(p, v, __ATOMIC_RELAXED, __HIP_MEMORY_SCOPE_AGENT); }
__device__ __forceinline__ unsigned xb_xcc_id() { return (unsigned)__builtin_amdgcn_s_getreg((3 << 11) | 20) & 0xFu; }
#define XB_SPIN(cond, bar) do { unsigned _sp = 0; while (cond) { __builtin_amdgcn_s_sleep(1); \
    if ((++_sp & 255u) == 0u) { if (xb_ld(&(bar)[XB_TMO])) break; if (_sp > XB_SPIN_CAP) { atomicAdd(&(bar)[XB_TMO], 1u); break; } } } } while (0)

struct XcdBarrier {
    unsigned* bar; unsigned x;
    volatile LAS unsigned* st;
};

__device__ __forceinline__ XcdBarrier xcd_barrier_post(unsigned* bar, volatile LAS unsigned* st) {
    XcdBarrier b; b.bar = bar; b.x = xb_xcc_id(); b.st = st;
    if (threadIdx.x == 0) (void)xb_add(&bar[XB_XCNT(b.x)], 1u);
    return b;
}
__device__ __forceinline__ void xcd_barrier_complete(unsigned* bar, unsigned x, unsigned& nloc, unsigned& nx) {
    const unsigned G = gridDim.x * gridDim.y * gridDim.z;
    unsigned sum, cnt, mine, sp = 0u;
    for (;;) {
        sum = 0u; cnt = 0u; mine = 0u;
#pragma unroll
        for (unsigned j = 0; j < 16; ++j) { const unsigned c = xb_ld(&bar[XB_XCNT(j)]); sum += c; cnt += (c > 0u) ? 1u : 0u; mine = (j == x) ? c : mine; }
        if (sum == G) break;
        __builtin_amdgcn_s_sleep(1);
        if ((++sp & 255u) == 0u) { if (xb_ld(&bar[XB_TMO])) break; if (sp > XB_SPIN_CAP) { atomicAdd(&bar[XB_TMO], 1u); break; } }
    }
    nloc = mine > 0u ? mine : 1u; nx = cnt > 0u ? cnt : 1u;
}

__device__ __forceinline__ void xcd_barrier(const XcdBarrier& b) {
    asm volatile("s_waitcnt vmcnt(0)" ::: "memory");
    __syncthreads();
    if (threadIdx.x == 0) {
        unsigned* bar = b.bar;
        __builtin_amdgcn_s_waitcnt(0);
        unsigned nloc = b.st[0], nx = b.st[1];
        if (nloc == 0u) { xcd_barrier_complete(bar, b.x, nloc, nx); b.st[0] = nloc; b.st[1] = nx; }
        const unsigned old = xb_add(&bar[XB_XSUB(b.x)], 1u);
        const unsigned gen = old / nloc;
        if (old + 1u == (gen + 1u) * nloc) {
            __builtin_amdgcn_fence(__ATOMIC_RELEASE, "agent");
            asm volatile("s_waitcnt vmcnt(0)" ::: "memory");
            const unsigned og = xb_add(&bar[XB_TOP], 1u);
            const unsigned tg = og / nx;
            if (og + 1u == (tg + 1u) * nx) xb_add(&bar[XB_TOPGEN], 1u);
            else XB_SPIN(xb_ld(&bar[XB_TOPGEN]) == tg, bar);
            __builtin_amdgcn_fence(__ATOMIC_ACQUIRE, "agent");
            xb_add(&bar[XB_XGEN(b.x)], 1u);
            asm volatile("s_waitcnt vmcnt(0)" ::: "memory");
        } else {
            XB_SPIN(xb_ld(&bar[XB_XGEN(b.x)]) == gen, bar);
            __builtin_amdgcn_fence(__ATOMIC_ACQUIRE, "agent");
            asm volatile("s_waitcnt vmcnt(0)" ::: "memory");
        }
    }
    __syncthreads();
}
constexpr int NWAVES = 8;
constexpr int DM = 2048, PB = 4, PL = 2048, MP = PB * PL, SB = 8, SL = 8, MS = SB * SL, MREAL = MP + MS, MT = 8448;
constexpr int NIN = 11264, DFF = 5632, NH = 8, HDK = 128, HDV = 128, DAH = 8, DADH = 64, DADV = 128;
constexpr int PAST = 16384, PAGE = 128, NPAGES = PAST / PAGE, NPOOL = 1280;
constexpr int C_HQ = 0, C_HF = 1024, C_HI = 2048, C_HGATE = 3072, C_DQ = 4096, C_DK = 5120, C_DV = 6144, C_GHG = 7168, C_GDA = 9216;
constexpr int OPITCH = 2048;
constexpr float RMS_EPS = 1e-6f, LOG2E = 1.4426950408889634f;
constexpr float QSCALE = 0.125f * LOG2E;
constexpr float LAM_INIT = 0.2f;
constexpr size_t O_YP = 0, O_YS = O_YP + (size_t)MP * DM, O_KP = O_YS + (size_t)MS * DM, O_VP = O_KP + (size_t)MP * 1024, O_SP = O_VP + (size_t)MP * 1024,
                 O_KS = O_SP + (size_t)PB * NH * HDK * HDV, O_VS = O_KS + (size_t)MS * 1024, O_SS = O_VS + (size_t)MS * 1024, O_END = O_SS + (size_t)SB * NH * HDK * HDV;
constexpr size_t MiB = 1u << 20;
constexpr size_t WS_CTL = 0, CTL_ZERO_BYTES = 1 * MiB;
constexpr size_t WS_WIN = 2 * MiB, WS_WBH = 48 * MiB, WS_WBD = 48 * MiB + 2048, WS_WOUT = 60 * MiB, WS_WUP = 70 * MiB, WS_WDN = 116 * MiB;
constexpr size_t WS_XN = 140 * MiB, WS_U = 176 * MiB, WS_G = 360 * MiB, WS_OHG = 396 * MiB, WS_ODA = 396 * MiB + 2048, WS_T1 = 432 * MiB, WS_MIX = 500 * MiB,
                 WS_Y1 = 536 * MiB, WS_X1 = 604 * MiB, WS_XN2 = 672 * MiB, WS_HID = 708 * MiB, WS_Y2 = 800 * MiB, WS_DEC = 868 * MiB, WS_X = 904 * MiB, WS_END = 906 * MiB;
static_assert(WS_WIN + (size_t)NIN * DM * 2 <= WS_WBH && WS_WUP + (size_t)NIN * DM * 2 <= WS_WDN && WS_WDN + (size_t)DM * DFF * 2 <= WS_XN && WS_XN + (size_t)MT * DM * 2 <= WS_U &&
              WS_U + (size_t)MT * NIN * 2 <= WS_G && WS_G + (size_t)MT * 1024 * 4 <= WS_OHG && WS_OHG + (size_t)MT * 2048 * 2 <= WS_T1 && WS_WBH + (size_t)DM * 2048 * 2 <= WS_WOUT &&
              WS_T1 + (size_t)MT * DM * 4 <= WS_MIX && WS_MIX + (size_t)MT * DM * 2 <= WS_Y1 && WS_Y1 + (size_t)MT * DM * 4 <= WS_X1 && WS_X1 + (size_t)MT * DM * 4 <= WS_XN2 &&
              WS_XN2 + (size_t)MT * DM * 2 <= WS_HID && WS_HID + (size_t)MT * DFF * 2 <= WS_Y2 && WS_Y2 + (size_t)MT * DM * 4 <= WS_DEC, "d_ws map");
constexpr int CW_TMO = 0, CW_CODE = 1, CW_Q = 64, CW_DCNT = 1024, CW_BAR = 4096, CW_SEAM = 40000, CW_THIN = 60000;
constexpr int RING_OFF = 0, RING_BYTES = 131072;
constexpr int LDSCTL_OFF = RING_BYTES, MISC_OFF = LDSCTL_OFF + 320;
constexpr int LDS_BYTES = 147456;
static_assert(MISC_OFF + 128 <= LDS_BYTES, "LDS map");
struct Args { const float* in[24]; const int* page_table; float* out; unsigned char* ws; int ph_lo, ph_hi, p2mask, pad; };
struct Frame {
    LAS unsigned char* lds; volatile LAS unsigned* MISC; gu32* ctl;
    int tid, lane, wave, vcu, G;
};
__device__ __forceinline__ float wave_sum(float v) {
#pragma unroll
    for (int o = 1; o < 64; o <<= 1) v += __shfl_xor(v, o);
    return v;
}
__device__ __forceinline__ float bf2f(bf16 h) { return __uint_as_float((unsigned)h << 16); }
__device__ __forceinline__ int t5_bucket(int n) {
    if (n < 16) return n;
    if (n >= 113) return 31;
    int b = 16;
    b += (n >= 19); b += (n >= 21); b += (n >= 24); b += (n >= 27); b += (n >= 31); b += (n >= 35); b += (n >= 40); b += (n >= 46);
    b += (n >= 52); b += (n >= 59); b += (n >= 67); b += (n >= 77); b += (n >= 87); b += (n >= 99);
    return b;
}
__device__ __forceinline__ float da_lambda(const Args& a) {
    float s1 = 0.f, s2 = 0.f;
    for (int i = 0; i < DADH; ++i) { s1 += a.in[13][i] * a.in[14][i]; s2 += a.in[15][i] * a.in[16][i]; }
    return expf(s1) - expf(s2) + LAM_INIT;
}
__device__ __forceinline__ void p0_transpose_item(const float* W, int K, int N, bf16* WT, int k0, int n0, int dst_row0, LAS float* scr, int lane, int ldt = 0) {
    if (ldt == 0) ldt = K;
#pragma unroll
    for (int i = 0; i < 8; ++i) { const int kk = 8 * i + (lane >> 3); const f32x4 t = *(const f32x4*)(W + (size_t)(k0 + kk) * N + n0 + 4 * (lane & 7));
        LAS float* d = scr + kk * 33 + 4 * (lane & 7); d[0] = t.x; d[1] = t.y; d[2] = t.z; d[3] = t.w; }
    LDS_WAIT(); asm volatile("" ::: "memory");
    const int c = lane & 7;
#pragma unroll
    for (int j = 0; j < 4; ++j) { const int n = (lane >> 3) + 8 * j; const LAS float* s = scr + (8 * c) * 33 + n;
        v4u o; o.x = pk2(s[0 * 33], s[1 * 33]); o.y = pk2(s[2 * 33], s[3 * 33]); o.z = pk2(s[4 * 33], s[5 * 33]); o.w = pk2(s[6 * 33], s[7 * 33]);
        *(GAS v4u*)(WT + (size_t)(dst_row0 + n) * ldt + k0 + 8 * c) = o; }
    LDS_WAIT(); asm volatile("" ::: "memory");
}
__device__ __forceinline__ void rms_row_to_bf16(const float* xrow, const float* w, bf16* orow, int lane) {
    GAS unsigned long long* o8 = (GAS unsigned long long*)orow + lane;
    if (!xrow) {
#pragma unroll
        for (int j = 0; j < 8; ++j) o8[64 * j] = 0ull;
        return; }
    const GAS f32x4* xr = (const GAS f32x4*)xrow + lane; const GAS f32x4* wr = (const GAS f32x4*)w + lane;
    f32x4 v[8]; float s = 0.f;
#pragma unroll
    for (int j = 0; j < 8; ++j) { v[j] = xr[64 * j]; s += (v[j].x * v[j].x + v[j].y * v[j].y) + (v[j].z * v[j].z + v[j].w * v[j].w); }
    const float rstd = 1.0f / sqrtf(wave_sum(s) * (1.0f / DM) + RMS_EPS);
#pragma unroll
    for (int j = 0; j < 8; ++j) { const f32x4 g = wr[64 * j]; o8[64 * j] = (unsigned long long)pk2(v[j].x * rstd * g.x, v[j].y * rstd * g.y) | ((unsigned long long)pk2(v[j].z * rstd * g.z, v[j].w * rstd * g.w) << 32); }
}
__device__ __forceinline__ void rms_rows2_to_bf16(const float* x0, const float* x1, bool has1, const float* w, bf16* o0, bf16* o1, int lane) {
    const GAS f32x4* wr = (const GAS f32x4*)w + lane;
    f32x4 v0[8], v1[8];
#pragma unroll
    for (int j = 0; j < 8; ++j) { v0[j] = x0 ? ((const GAS f32x4*)x0 + lane)[64 * j] : (f32x4){0.f, 0.f, 0.f, 0.f}; v1[j] = x1 ? ((const GAS f32x4*)x1 + lane)[64 * j] : (f32x4){0.f, 0.f, 0.f, 0.f}; }
    float s0 = 0.f, s1 = 0.f;
#pragma unroll
    for (int j = 0; j < 8; ++j) { s0 += (v0[j].x * v0[j].x + v0[j].y * v0[j].y) + (v0[j].z * v0[j].z + v0[j].w * v0[j].w); s1 += (v1[j].x * v1[j].x + v1[j].y * v1[j].y) + (v1[j].z * v1[j].z + v1[j].w * v1[j].w); }
    const float r0 = 1.0f / sqrtf(wave_sum(s0) * (1.0f / DM) + RMS_EPS), r1 = 1.0f / sqrtf(wave_sum(s1) * (1.0f / DM) + RMS_EPS);
    GAS unsigned long long* p0 = (GAS unsigned long long*)o0 + lane; GAS unsigned long long* p1 = (GAS unsigned long long*)o1 + lane;
#pragma unroll
    for (int j = 0; j < 8; ++j) { const f32x4 g = wr[64 * j];
        p0[64 * j] = (unsigned long long)pk2(v0[j].x * r0 * g.x, v0[j].y * r0 * g.y) | ((unsigned long long)pk2(v0[j].z * r0 * g.z, v0[j].w * r0 * g.w) << 32);
        if (has1) p1[64 * j] = (unsigned long long)pk2(v1[j].x * r1 * g.x, v1[j].y * r1 * g.y) | ((unsigned long long)pk2(v1[j].z * r1 * g.z, v1[j].w * r1 * g.w) << 32); }
}
__device__ __forceinline__ const float* x_row(const Args& a, int m) { return m < MP ? a.in[0] + (size_t)m * DM : (m < MREAL ? a.in[1] + (size_t)(m - MP) * DM : nullptr); }

constexpr int I_IN = (DM / 64) * (NIN / 32), I_BH = (1024 / 64) * (DM / 32), I_OUT = (DM / 64) * (DM / 32), I_UP = I_IN, I_DN = (DFF / 64) * (DM / 32);
constexpr int NITEMS_LATE = 2 * I_BH + I_OUT + I_UP;
struct XItem { const float* src; bf16* dst; int N, ldt; };
__device__ __forceinline__ XItem late_item(const Args& a, int r) {
    unsigned char* ws = a.ws; XItem x;
    if (r < I_BH) { const int nb = DM / 32, kb = r / nb, n0 = 32 * (r % nb); x.src = a.in[19] + (size_t)(64 * kb) * DM + n0; x.dst = (bf16*)(ws + WS_WBH) + (size_t)n0 * OPITCH + 64 * kb; x.N = DM; x.ldt = OPITCH; return x; } r -= I_BH;
    if (r < I_BH) { const int nb = DM / 32, kb = r / nb, n0 = 32 * (r % nb); x.src = a.in[20] + (size_t)(64 * kb) * DM + n0; x.dst = (bf16*)(ws + WS_WBD) + (size_t)n0 * OPITCH + 64 * kb; x.N = DM; x.ldt = OPITCH; return x; } r -= I_BH;
    if (r < I_OUT) { const int nb = DM / 32, kb = r / nb, n0 = 32 * (r % nb); x.src = a.in[21] + (size_t)(64 * kb) * DM + n0; x.dst = (bf16*)(ws + WS_WOUT) + (size_t)n0 * DM + 64 * kb; x.N = DM; x.ldt = DM; return x; } r -= I_OUT;
    { const int nb = NIN / 32, kb = r / nb, n0 = 32 * (r % nb);
      const int isup = n0 >= DFF, nn = isup ? n0 - DFF : n0, dr = 256 * (nn / 128) + (isup ? 128 : 0) + (nn % 128);
      x.src = a.in[22] + (size_t)(64 * kb) * NIN + n0; x.dst = (bf16*)(ws + WS_WUP) + (size_t)dr * DM + 64 * kb; x.N = NIN; x.ldt = DM; return x; }
}
__device__ __forceinline__ XItem dn_item(const Args& a, int r) { const int nb = DM / 32, kb = r / nb, n0 = 32 * (r % nb); XItem x; x.src = a.in[23] + (size_t)(64 * kb) * DM + n0; x.dst = (bf16*)(a.ws + WS_WDN) + (size_t)n0 * DFF + 64 * kb; x.N = DM; x.ldt = DFF; return x; }
__device__ __forceinline__ void x_load(const XItem& x, int lane, f32x4 (&t)[8]) {
#pragma unroll
    for (int i = 0; i < 8; ++i) t[i] = *(const GAS f32x4*)(x.src + (size_t)(8 * i + (lane >> 3)) * x.N + 4 * (lane & 7));
}
__device__ __forceinline__ void x_finish(const XItem& x, const f32x4 (&t)[8], LAS float* scr, int lane) {
#pragma unroll
    for (int i = 0; i < 8; ++i) { LAS float* d = scr + (8 * i + (lane >> 3)) * 33 + 4 * (lane & 7); d[0] = t[i].x; d[1] = t[i].y; d[2] = t[i].z; d[3] = t[i].w; }
    LDS_WAIT(); asm volatile("" ::: "memory");
    const int c = lane & 7;
#pragma unroll
    for (int j = 0; j < 4; ++j) { const int n = (lane >> 3) + 8 * j; const LAS float* s = scr + (8 * c) * 33 + n;
        v4u o; o.x = pk2(s[0 * 33], s[1 * 33]); o.y = pk2(s[2 * 33], s[3 * 33]); o.z = pk2(s[4 * 33], s[5 * 33]); o.w = pk2(s[6 * 33], s[7 * 33]);
        *(GAS v4u*)(x.dst + (size_t)n * x.ldt + 8 * c) = o; }
    LDS_WAIT(); asm volatile("" ::: "memory");
}
template <bool DN>
__device__ __forceinline__ void convert_from_counter(Frame& F, const Args& a, gu32* ctr) {
    constexpr int NIT = DN ? I_DN : NITEMS_LATE; static_assert(NIT % 8 == 0, "batches of 8");
    LAS float* scr = (LAS float*)(F.lds + RING_OFF + F.wave * 16384);
    for (;;) {
        unsigned it = 0; if (F.lane == 0) it = __hip_atomic_fetch_add(ctr, 8u, RLX_AGENT);
        it = (unsigned)__builtin_amdgcn_readfirstlane((int)it);
        if (it >= (unsigned)NIT) break;
        f32x4 ta[8], tb[8];
        XItem xa = DN ? dn_item(a, (int)it) : late_item(a, (int)it), xb;
        x_load(xa, F.lane, ta);
#pragma unroll
        for (int p = 0; p < 4; ++p) {
            xb = DN ? dn_item(a, (int)it + 2 * p + 1) : late_item(a, (int)it + 2 * p + 1); x_load(xb, F.lane, tb);
            x_finish(xa, ta, scr, F.lane);
            if (p < 3) { xa = DN ? dn_item(a, (int)it + 2 * p + 2) : late_item(a, (int)it + 2 * p + 2); x_load(xa, F.lane, ta); }
            x_finish(xb, tb, scr, F.lane);
        }
    }
}
__device__ __forceinline__ void convert_late(Frame& F, const Args& a, gu32* ctr) { convert_from_counter<false>(F, a, ctr); }
__device__ __forceinline__ void convert_dn(Frame& F, const Args& a, gu32* ctr) { convert_from_counter<true>(F, a, ctr); }
__device__ __forceinline__ void p0_prologue(Frame& F, const Args& a) {
    unsigned char* ws = a.ws;
    LAS float* scr = (LAS float*)(F.lds + RING_OFF + F.wave * 16384);
    const int gw = F.vcu * NWAVES + F.wave, NGW = F.G * NWAVES;
    for (int p = gw; p < I_IN / 2; p += NGW) {
        const int nb = NIN / 32; XItem xa, xb; f32x4 ta[8], tb[8];
        { const int it = 2 * p, kb = it / nb, n0 = 32 * (it % nb); xa.src = a.in[10] + (size_t)(64 * kb) * NIN + n0; xa.dst = (bf16*)(ws + WS_WIN) + (size_t)n0 * DM + 64 * kb; xa.N = NIN; xa.ldt = DM; }
        { const int it = 2 * p + 1, kb = it / nb, n0 = 32 * (it % nb); xb.src = a.in[10] + (size_t)(64 * kb) * NIN + n0; xb.dst = (bf16*)(ws + WS_WIN) + (size_t)n0 * DM + 64 * kb; xb.N = NIN; xb.ldt = DM; }
        x_load(xa, F.lane, ta); x_load(xb, F.lane, tb); x_finish(xa, ta, scr, F.lane); x_finish(xb, tb, scr, F.lane); }
    for (int m = gw; m < MT; m += 2 * NGW) rms_rows2_to_bf16(x_row(a, m), m + NGW < MT ? x_row(a, m + NGW) : nullptr, m + NGW < MT, a.in[6], (bf16*)(ws + WS_XN) + (size_t)m * DM, (bf16*)(ws + WS_XN) + (size_t)(m + NGW) * DM, F.lane);
    for (int m = MREAL + gw; m < MT; m += NGW) { rms_row_to_bf16(nullptr, nullptr, (bf16*)(ws + WS_OHG) + (size_t)m * OPITCH, F.lane); rms_row_to_bf16(nullptr, nullptr, (bf16*)(ws + WS_XN2) + (size_t)m * DM, F.lane); }
}
__device__ __forceinline__ f32x4 bf4(unsigned long long w) { const unsigned lo = (unsigned)w, hi = (unsigned)(w >> 32); return (f32x4){__uint_as_float(lo << 16), __uint_as_float(lo & 0xffff0000u), __uint_as_float(hi << 16), __uint_as_float(hi & 0xffff0000u)}; }
template <int NR>
__device__ __forceinline__ void row1(const Args& a, int m0, int stride, int lane) {
    unsigned char* ws = a.ws;
    const GAS f32x4* w1 = (const GAS f32x4*)a.in[7] + lane; const GAS f32x4* w2 = (const GAS f32x4*)a.in[8] + lane;
    unsigned long long yw[NR][8]; f32x4 xv[NR][8];
#pragma unroll
    for (int i = 0; i < NR; ++i) { const int m = m0 + i * stride; if (m < MREAL) {
        const GAS unsigned long long* yr = (const GAS unsigned long long*)((const bf16*)(ws + WS_Y1) + (size_t)m * DM) + lane; const GAS f32x4* xr = (const GAS f32x4*)x_row(a, m) + lane;
#pragma unroll
        for (int j = 0; j < 8; ++j) { yw[i][j] = yr[64 * j]; xv[i][j] = xr[64 * j]; } } }
    f32x4 g1[8];
#pragma unroll
    for (int j = 0; j < 8; ++j) g1[j] = w1[64 * j];
#pragma unroll
    for (int i = 0; i < NR; ++i) { const int m = m0 + i * stride; if (m < MREAL) {
        GAS unsigned long long* o8 = (GAS unsigned long long*)((bf16*)(ws + WS_XN2) + (size_t)m * DM) + lane; GAS unsigned long long* x1o = (GAS unsigned long long*)((bf16*)(ws + WS_X1) + (size_t)m * DM) + lane;
        float s = 0.f;
#pragma unroll
        for (int j = 0; j < 8; ++j) { const f32x4 v = bf4(yw[i][j]); s += (v.x * v.x + v.y * v.y) + (v.z * v.z + v.w * v.w); }
        const float rstd = 1.0f / sqrtf(wave_sum(s) * (1.0f / DM) + RMS_EPS); float s2 = 0.f;
#pragma unroll
        for (int j = 0; j < 8; ++j) { const f32x4 t = xv[i][j] + bf4(yw[i][j]) * rstd * g1[j]; xv[i][j] = t; x1o[64 * j] = (unsigned long long)pk2(t.x, t.y) | ((unsigned long long)pk2(t.z, t.w) << 32); s2 += (t.x * t.x + t.y * t.y) + (t.z * t.z + t.w * t.w); }
        const float rstd2 = 1.0f / sqrtf(wave_sum(s2) * (1.0f / DM) + RMS_EPS);
#pragma unroll
        for (int j = 0; j < 8; ++j) { const f32x4 g = w2[64 * j]; o8[64 * j] = (unsigned long long)pk2(xv[i][j].x * rstd2 * g.x, xv[i][j].y * rstd2 * g.y) | ((unsigned long long)pk2(xv[i][j].z * rstd2 * g.z, xv[i][j].w * rstd2 * g.w) << 32); } } }
}
template <int NR>
__device__ __forceinline__ void row2(const Args& a, int m0, int stride, int lane) {
    unsigned char* ws = a.ws;
    const GAS f32x4* w1 = (const GAS f32x4*)a.in[9] + lane;
    f32x4 v[NR][8]; unsigned long long xw[NR][8];
#pragma unroll
    for (int i = 0; i < NR; ++i) { const int m = m0 + i * stride; if (m < MREAL) {
        const GAS unsigned long long* yr = (const GAS unsigned long long*)((const bf16*)(ws + WS_Y2) + (size_t)m * DM) + lane; const GAS unsigned long long* xr = (const GAS unsigned long long*)((const bf16*)(ws + WS_X1) + (size_t)m * DM) + lane;
#pragma unroll
        for (int j = 0; j < 8; ++j) { v[i][j] = bf4(yr[64 * j]); xw[i][j] = xr[64 * j]; } } }
#pragma unroll
    for (int i = 0; i < NR; ++i) { const int m = m0 + i * stride; if (m < MREAL) {
        GAS f32x4* o = (GAS f32x4*)(m < MP ? a.out + O_YP + (size_t)m * DM : a.out + O_YS + (size_t)(m - MP) * DM) + lane;
        float s = 0.f;
#pragma unroll
        for (int j = 0; j < 8; ++j) s += (v[i][j].x * v[i][j].x + v[i][j].y * v[i][j].y) + (v[i][j].z * v[i][j].z + v[i][j].w * v[i][j].w);
        const float rstd = 1.0f / sqrtf(wave_sum(s) * (1.0f / DM) + RMS_EPS);
#pragma unroll
        for (int j = 0; j < 8; ++j) o[64 * j] = bf4(xw[i][j]) + v[i][j] * rstd * w1[64 * j]; } }
}
__device__ __forceinline__ void row_pass1(Frame& F, const Args& a) { int ln = threadIdx.x; asm volatile("" : "+v"(ln)); ln &= 63;
    const int gw = F.vcu * NWAVES + F.wave, NGW = F.G * NWAVES; for (int m = gw; m < MREAL; m += 3 * NGW) row1<3>(a, m, NGW, ln); }
__device__ __forceinline__ void row_pass2(Frame& F, const Args& a) { int ln = threadIdx.x; asm volatile("" : "+v"(ln)); ln &= 63;
    const int gw = F.vcu * NWAVES + F.wave, NGW = F.G * NWAVES; for (int m = gw; m < MREAL; m += 2 * NGW) row2<2>(a, m, NGW, ln); }
#ifndef PROBE_PHASE
#define PROBE_PHASE -1
#endif
#define HG_PROBE_MUL ((PROBE_PHASE == 23) ? 2 : 1)
namespace hg {
typedef short bf16x8 __attribute__((ext_vector_type(8)));
typedef short s16x4 __attribute__((ext_vector_type(4)));
typedef float f32x4 __attribute__((ext_vector_type(4)));
typedef float f32x2 __attribute__((ext_vector_type(2)));
typedef unsigned u32x2 __attribute__((ext_vector_type(2)));
typedef unsigned u32x4 __attribute__((ext_vector_type(4)));
constexpr int QS_P = 272, KT_P = 144, VS_P = 272, AM_P = 144, OB_P = 528;
constexpr int QS = 0, KS = QS + 64 * QS_P, KT = KS + 64 * QS_P, VS = KT + 128 * KT_P, AM = VS + 64 * VS_P, GS = AM + 64 * AM_P, DEC = GS + 8 * 128 * 4, NWL = DEC + 512, LDS_END = NWL + 512;
constexpr int OB = 0;
static_assert(64 * OB_P <= KT && LDS_END <= 131072, "hgrn LDS map");
__device__ __forceinline__ unsigned pkbf(float lo, float hi) { unsigned r; asm volatile("v_cvt_pk_bf16_f32 %0, %1, %2" : "=v"(r) : "v"(lo), "v"(hi)); return r; }
__device__ __forceinline__ float lo2f(unsigned w) { return __uint_as_float(w << 16); }
__device__ __forceinline__ float hi2f(unsigned w) { return __uint_as_float(w & 0xffff0000u); }
__device__ __forceinline__ s16x4 trd(const LAS unsigned char* p) { typedef short v4i16_t __attribute__((ext_vector_type(4))); return __builtin_bit_cast(s16x4, __builtin_amdgcn_ds_read_tr16_b64_v4i16((LAS v4i16_t*)p)); }
#define HG_BAR() do { asm volatile("s_waitcnt vmcnt(0) lgkmcnt(0)" ::: "memory"); __builtin_amdgcn_s_barrier(); asm volatile("" ::: "memory"); } while (0)
#define HG_LBAR() do { asm volatile("s_waitcnt lgkmcnt(0)" ::: "memory"); __builtin_amdgcn_s_barrier(); asm volatile("" ::: "memory"); } while (0)

__device__ __forceinline__ void prompt_unit(LAS unsigned char* lds, const Args& a, int b, int h) {
    int tid = threadIdx.x; asm volatile("" : "+v"(tid));
    const int lane = tid & 63, w = __builtin_amdgcn_readfirstlane(tid >> 6), q = lane >> 4, li = lane & 15;
    const bf16* U = (const bf16*)(a.ws + WS_U); const float* G = (const float*)(a.ws + WS_G); bf16* OHG = (bf16*)(a.ws + WS_OHG);
    const size_t rbase = (size_t)b * PL;
    if (tid < 128) ((LAS float*)(lds + NWL))[tid] = a.in[12][tid];
    f32x4 S[8];
#pragma unroll
    for (int i = 0; i < 8; ++i) S[i] = (f32x4){0.f, 0.f, 0.f, 0.f};
    f32x2 g2[8]; unsigned qv[8], kv[8]; u32x4 vv[2];
#define HG_PREFETCH(n) do { _Pragma("unroll") for (int r = 0; r < 8; ++r) { const size_t row = rbase + (size_t)(n) * 64 + 8 * w + r; \
            g2[r] = *(const f32x2*)(G + row * 1024 + h * HDK + 2 * lane); qv[r] = *(const unsigned*)(U + row * NIN + C_HQ + h * HDK + 2 * lane); kv[r] = *(const unsigned*)(U + row * NIN + C_HF + h * HDK + 2 * lane); } \
        { const bf16* vp = U + (rbase + (size_t)(n) * 64 + (tid >> 3)) * NIN + C_HI + h * HDV + (tid & 7) * 16; vv[0] = *(const u32x4*)vp; vv[1] = *(const u32x4*)(vp + 8); } } while (0)
    HG_PREFETCH(0);
    for (int nn = 0; nn < (PL / 64) * HG_PROBE_MUL; ++nn) { const int n = nn & (PL / 64 - 1);
        if (HG_PROBE_MUL > 1 && nn == PL / 64) {
#pragma unroll
            for (int i = 0; i < 8; ++i) S[i] = (f32x4){0.f, 0.f, 0.f, 0.f}; }
        float c0[8], c1[8];
        { float s0 = 0.f, s1 = 0.f;
#pragma unroll
          for (int r = 0; r < 8; ++r) { s0 += g2[r].x * LOG2E; s1 += g2[r].y * LOG2E; c0[r] = s0; c1[r] = s1; }
          *(LAS f32x2*)(lds + GS + (w * 128 + 2 * lane) * 4) = (f32x2){s0, s1}; }
        HG_LBAR();
        float off0 = 0.f, off1 = 0.f, tot0 = 0.f, tot1 = 0.f;
#pragma unroll
        for (int j = 0; j < 8; ++j) { const f32x2 t = *(const LAS f32x2*)(lds + GS + (j * 128 + 2 * lane) * 4); tot0 += t.x; tot1 += t.y; if (j < w) { off0 += t.x; off1 += t.y; } }
        const float dl0 = __builtin_amdgcn_exp2f(tot0), dl1 = __builtin_amdgcn_exp2f(tot1);
        if (w == 0) *(LAS f32x2*)(lds + DEC + 2 * lane * 4) = (f32x2){dl0, dl1};
        float kd0[8], kd1[8];
#pragma unroll
        for (int r = 0; r < 8; ++r) { const float G0 = off0 + c0[r], G1 = off1 + c1[r];
            const float e0 = __builtin_amdgcn_exp2f(G0), e1 = __builtin_amdgcn_exp2f(G1), i0 = __builtin_amdgcn_exp2f(-G0), i1 = __builtin_amdgcn_exp2f(-G1);
            const float kg0 = lo2f(kv[r]) * i0, kg1 = hi2f(kv[r]) * i1;
            *(LAS unsigned*)(lds + QS + (8 * w + r) * QS_P + lane * 4) = pkbf(lo2f(qv[r]) * e0, hi2f(qv[r]) * e1);
            *(LAS unsigned*)(lds + KS + (8 * w + r) * QS_P + lane * 4) = pkbf(kg0, kg1);
            kd0[r] = kg0 * dl0; kd1[r] = kg1 * dl1; }
        *(LAS u32x4*)(lds + KT + (2 * lane) * KT_P + w * 16) = (u32x4){pkbf(kd0[0], kd0[1]), pkbf(kd0[2], kd0[3]), pkbf(kd0[4], kd0[5]), pkbf(kd0[6], kd0[7])};
        *(LAS u32x4*)(lds + KT + (2 * lane + 1) * KT_P + w * 16) = (u32x4){pkbf(kd1[0], kd1[1]), pkbf(kd1[2], kd1[3]), pkbf(kd1[4], kd1[5]), pkbf(kd1[6], kd1[7])};
        *(LAS u32x4*)(lds + VS + (tid >> 3) * VS_P + (tid & 7) * 32) = vv[0]; *(LAS u32x4*)(lds + VS + (tid >> 3) * VS_P + (tid & 7) * 32 + 16) = vv[1];
        HG_LBAR();
        if (nn + 1 < (PL / 64) * HG_PROBE_MUL) HG_PREFETCH((n + 1) & (PL / 64 - 1));
        u32x4 gt0, gt1; { const bf16* gp = U + (rbase + (size_t)n * 64 + (tid >> 3)) * NIN + C_HGATE + h * HDV + (tid & 7) * 16; gt0 = *(const u32x4*)gp; gt1 = *(const u32x4*)(gp + 8); }
#pragma unroll
        for (int tt = 0; tt < 2; ++tt) { const int t = 2 * w + tt, ci = t >> 2, si = t & 3;
            f32x4 acc = (f32x4){0.f, 0.f, 0.f, 0.f};
#pragma unroll
            for (int kd = 0; kd < 4; ++kd) { const bf16x8 af = *(const LAS bf16x8*)(lds + KS + (16 * si + li) * QS_P + (32 * kd + 8 * q) * 2), bf = *(const LAS bf16x8*)(lds + QS + (16 * ci + li) * QS_P + (32 * kd + 8 * q) * 2);
                acc = __builtin_amdgcn_mfma_f32_16x16x32_bf16(af, bf, acc, 0, 0, 0); }
            const int cc = 16 * ci + li, sb = 16 * si + 4 * q;
#pragma unroll
            for (int r = 0; r < 4; ++r) if (sb + r > cc) acc[r] = 0.f;
            *(LAS u32x2*)(lds + AM + cc * AM_P + sb * 2) = (u32x2){pkbf(acc[0], acc[1]), pkbf(acc[2], acc[3])}; }
        f32x4 O[4];
#pragma unroll
        for (int m = 0; m < 4; ++m) O[m] = (f32x4){0.f, 0.f, 0.f, 0.f};
#pragma unroll
        for (int ks = 0; ks < 4; ++ks) { const u32x4 sb4 = (u32x4){pkbf(S[2 * ks][0], S[2 * ks][1]), pkbf(S[2 * ks][2], S[2 * ks][3]), pkbf(S[2 * ks + 1][0], S[2 * ks + 1][1]), pkbf(S[2 * ks + 1][2], S[2 * ks + 1][3])};
            const bf16x8 sb = __builtin_bit_cast(bf16x8, sb4);
#pragma unroll
            for (int m = 0; m < 4; ++m) { const u32x2 a0 = *(const LAS u32x2*)(lds + QS + (16 * m + li) * QS_P + (32 * ks + 4 * q) * 2), a1 = *(const LAS u32x2*)(lds + QS + (16 * m + li) * QS_P + (32 * ks + 16 + 4 * q) * 2);
                const bf16x8 af = __builtin_bit_cast(bf16x8, (u32x4){a0.x, a0.y, a1.x, a1.y});
                O[m] = __builtin_amdgcn_mfma_f32_16x16x32_bf16(af, sb, O[m], 0, 0, 0); } }
        bf16x8 Vf[2];
#pragma unroll
        for (int k2 = 0; k2 < 2; ++k2) { const LAS unsigned char* vp = lds + VS + (32 * k2 + 8 * q + (li >> 2)) * VS_P + (16 * w + 4 * (li & 3)) * 2;
            const s16x4 lo = trd(vp), hi = trd(vp + 4 * VS_P); Vf[k2] = (bf16x8){lo[0], lo[1], lo[2], lo[3], hi[0], hi[1], hi[2], hi[3]}; }
#pragma unroll
        for (int dt = 0; dt < 8; ++dt) { const f32x4 dc = *(const LAS f32x4*)(lds + DEC + (16 * dt + 4 * q) * 4); S[dt] = S[dt] * dc;
#pragma unroll
            for (int k2 = 0; k2 < 2; ++k2) { const bf16x8 af = *(const LAS bf16x8*)(lds + KT + (16 * dt + li) * KT_P + (32 * k2 + 8 * q) * 2);
                S[dt] = __builtin_amdgcn_mfma_f32_16x16x32_bf16(af, Vf[k2], S[dt], 0, 0, 0); } }
        HG_LBAR();
#pragma unroll
        for (int m = 0; m < 4; ++m)
#pragma unroll
            for (int k2 = 0; k2 < 2; ++k2) { if (32 * k2 > 16 * m + 15) continue;
                const bf16x8 af = *(const LAS bf16x8*)(lds + AM + (16 * m + li) * AM_P + (32 * k2 + 8 * q) * 2);
                O[m] = __builtin_amdgcn_mfma_f32_16x16x32_bf16(af, Vf[k2], O[m], 0, 0, 0); }
#pragma unroll
        for (int m = 0; m < 4; ++m)
#pragma unroll
            for (int r = 0; r < 4; ++r) *(LAS float*)(lds + OB + (16 * m + 4 * q + r) * OB_P + (16 * w + li) * 4) = O[m][r];
        HG_LBAR();
        { const int c = tid >> 3, sg = tid & 7; f32x4 x[4]; float ss = 0.f;
#pragma unroll
          for (int i = 0; i < 4; ++i) { x[i] = *(const LAS f32x4*)(lds + OB + c * OB_P + sg * 64 + i * 16); ss += (x[i][0] * x[i][0] + x[i][1] * x[i][1]) + (x[i][2] * x[i][2] + x[i][3] * x[i][3]); }
          ss += __shfl_xor(ss, 1); ss += __shfl_xor(ss, 2); ss += __shfl_xor(ss, 4);
          const float rstd = 1.0f / sqrtf(ss * (1.0f / HDV) + RMS_EPS);
          const unsigned gw[8] = {gt0.x, gt0.y, gt0.z, gt0.w, gt1.x, gt1.y, gt1.z, gt1.w}; unsigned ow[8];
#pragma unroll
          for (int i = 0; i < 4; ++i) { const f32x4 nw = *(const LAS f32x4*)(lds + NWL + (sg * 16 + i * 4) * 4);
              ow[2 * i] = pkbf(x[i][0] * rstd * nw[0] * lo2f(gw[2 * i]), x[i][1] * rstd * nw[1] * hi2f(gw[2 * i])); ow[2 * i + 1] = pkbf(x[i][2] * rstd * nw[2] * lo2f(gw[2 * i + 1]), x[i][3] * rstd * nw[3] * hi2f(gw[2 * i + 1])); }
          bf16* op = OHG + (rbase + (size_t)n * 64 + c) * OPITCH + h * HDV + sg * 16;
          *(u32x4*)op = (u32x4){ow[0], ow[1], ow[2], ow[3]}; *(u32x4*)(op + 8) = (u32x4){ow[4], ow[5], ow[6], ow[7]}; }
    }
#undef HG_PREFETCH
    float* So = a.out + O_SP + (size_t)(b * NH + h) * HDK * HDV;
#pragma unroll
    for (int dt = 0; dt < 8; ++dt)
#pragma unroll
        for (int r = 0; r < 4; ++r) So[(size_t)(16 * dt + 4 * q + r) * HDV + 16 * w + li] = S[dt][r];
    HG_BAR();
}

__device__ __forceinline__ void sample_unit(LAS unsigned char* lds, const Args& a, int s, int h) {
    int tid = threadIdx.x; asm volatile("" : "+v"(tid));
    const int v = tid & 127, dg = tid >> 7, lane = tid & 63, wave = tid >> 6;
    LAS float* Fd = (LAS float*)lds; LAS float* Qd = Fd + SL * 128; LAS float* Iv = Qd + SL * 128; LAS float* Gv = Iv + SL * 128; LAS float* red = Gv + SL * 128; LAS float* red2 = red + 512;
    const bf16* U = (const bf16*)(a.ws + WS_U); const float* G = (const float*)(a.ws + WS_G); bf16* OHG = (bf16*)(a.ws + WS_OHG);
    const float* S0 = a.in[4] + (size_t)(s * NH + h) * HDK * HDV; float* Sout = a.out + O_SS + (size_t)(s * NH + h) * HDK * HDV;
    float S[32];
#pragma unroll
    for (int i = 0; i < 32; ++i) S[i] = S0[(size_t)(dg * 32 + i) * HDV + v];
#pragma unroll
    for (int e = 0; e < 2; ++e) { const int idx = tid + 512 * e, t = idx >> 7, c = idx & 127; const size_t row = (size_t)(MP + s * SL + t);
        Fd[idx] = __expf(G[row * 1024 + h * HDK + c]); Qd[idx] = bf2f(U[row * NIN + C_HQ + h * HDK + c]); Iv[idx] = bf2f(U[row * NIN + C_HI + h * HDV + c]); Gv[idx] = bf2f(U[row * NIN + C_HGATE + h * HDV + c]); }
    const float nw = a.in[12][v];
    HG_LBAR();
    for (int t = 0; t < SL; ++t) {
        const float iv = Iv[t * 128 + v];
        float part = 0.f;
#pragma unroll
        for (int i4 = 0; i4 < 8; ++i4) { const f32x4 f4 = *(const LAS f32x4*)(Fd + t * 128 + dg * 32 + 4 * i4), q4 = *(const LAS f32x4*)(Qd + t * 128 + dg * 32 + 4 * i4);
#pragma unroll
            for (int e = 0; e < 4; ++e) { const int i = 4 * i4 + e; S[i] = f4[e] * S[i] + (1.0f - f4[e]) * iv; part += S[i] * q4[e]; } }
        red[dg * 128 + v] = part; HG_LBAR();
        const float o = (red[v] + red[128 + v]) + (red[256 + v] + red[384 + v]);
        if (dg == 0) { const float ss = wave_sum(o * o); if (lane == 0) red2[wave] = ss; }
        HG_LBAR();
        if (dg == 0) { const float rstd = 1.0f / sqrtf((red2[0] + red2[1]) * (1.0f / HDV) + RMS_EPS);
            OHG[(size_t)(MP + s * SL + t) * OPITCH + h * HDV + v] = (bf16)f2bf(o * rstd * nw * Gv[t * 128 + v]); }
    }
#pragma unroll
    for (int i = 0; i < 32; ++i) Sout[(size_t)(dg * 32 + i) * HDV + v] = S[i];
    HG_LBAR();
}
}
namespace at {
typedef short bf16x8 __attribute__((ext_vector_type(8)));
typedef short s16x4 __attribute__((ext_vector_type(4)));
typedef float f32x4 __attribute__((ext_vector_type(4)));
typedef unsigned u32x2 __attribute__((ext_vector_type(2)));
typedef unsigned u32x4 __attribute__((ext_vector_type(4)));
constexpr int KP = 144, VP = 288;
constexpr int K_BYTES = 64 * KP, V_BYTES = 64 * VP, STG = 2 * K_BYTES + V_BYTES;
constexpr int LUT = 2 * STG, WSC = LUT + 1024, LDS_END = WSC + 8 * 256;
static_assert(LDS_END <= 131072, "attention LDS map");
constexpr float NEG = -1e30f;
using hg::pkbf; using hg::trd; using hg::lo2f; using hg::hi2f;

__device__ __forceinline__ float gmax4(float x) {
    auto a = __builtin_amdgcn_permlane16_swap(__float_as_uint(x), __float_as_uint(x), false, false); x = fmaxf(__uint_as_float(a[0]), __uint_as_float(a[1]));
    auto b = __builtin_amdgcn_permlane32_swap(__float_as_uint(x), __float_as_uint(x), false, false); return fmaxf(__uint_as_float(b[0]), __uint_as_float(b[1]));
}
__device__ __forceinline__ void prompt_unit(LAS unsigned char* lds, const Args& a, int b, int h, int qb, float lam) {
    int tid = threadIdx.x; asm volatile("" : "+v"(tid));
    const int lane = tid & 63, w = __builtin_amdgcn_readfirstlane(tid >> 6), Q = lane >> 4, li = lane & 15;
    const bf16* U = (const bf16*)(a.ws + WS_U); bf16* ODA = (bf16*)(a.ws + WS_ODA);
    const size_t rbase = (size_t)b * PL;
    const int r0 = 128 * qb + 16 * w;
    const int NT = 2 * qb + 2;
    if (tid < 256) { const int mp = tid >> 7, d = tid & 127; ((LAS float*)(lds + LUT))[tid] = a.in[18][t5_bucket(d) * 16 + mp * 8 + h] * LOG2E; }
    const float c31a = a.in[18][31 * 16 + h] * LOG2E, c31b = a.in[18][31 * 16 + 8 + h] * LOG2E;
    bf16x8 qf[2][2];
#pragma unroll
    for (int mp = 0; mp < 2; ++mp)
#pragma unroll
        for (int ks = 0; ks < 2; ++ks) qf[mp][ks] = *(const bf16x8*)(U + (rbase + r0 + li) * NIN + C_DQ + (mp * 8 + h) * 64 + 32 * ks + 8 * Q);
    f32x4 OT[2][8];
#pragma unroll
    for (int mp = 0; mp < 2; ++mp)
#pragma unroll
        for (int vt = 0; vt < 8; ++vt) OT[mp][vt] = (f32x4){0.f, 0.f, 0.f, 0.f};
    float mref[2] = {0.f, 0.f};
    f32x4 LT[2] = {(f32x4){0.f, 0.f, 0.f, 0.f}, (f32x4){0.f, 0.f, 0.f, 0.f}};
    const bf16x8 ones = (bf16x8){0x3f80, 0x3f80, 0x3f80, 0x3f80, 0x3f80, 0x3f80, 0x3f80, 0x3f80};
    u32x4 st[4];
    const int srow = tid >> 3, sch = tid & 7;
#define AT_LOAD(t) do { const bf16* rp = U + (rbase + (size_t)(t) * 64 + srow) * NIN; \
        st[0] = *(const u32x4*)(rp + C_DK + h * 64 + sch * 8); st[1] = *(const u32x4*)(rp + C_DK + (8 + h) * 64 + sch * 8); \
        st[2] = *(const u32x4*)(rp + C_DV + h * 128 + sch * 16); st[3] = *(const u32x4*)(rp + C_DV + h * 128 + sch * 16 + 8); } while (0)
#define AT_STORE(buf) do { LAS unsigned char* sb = lds + (buf) * STG; \
        *(LAS u32x4*)(sb + srow * KP + sch * 16) = st[0]; *(LAS u32x4*)(sb + K_BYTES + srow * KP + sch * 16) = st[1]; \
        *(LAS u32x4*)(sb + 2 * K_BYTES + srow * VP + sch * 32) = st[2]; *(LAS u32x4*)(sb + 2 * K_BYTES + srow * VP + sch * 32 + 16) = st[3]; } while (0)
    AT_LOAD(0); AT_STORE(0);
    HG_LBAR();
    for (int t = 0; t < NT; ++t) {
        if (t + 1 < NT) AT_LOAD(t + 1);
        const int k0 = 64 * t;
        if (k0 <= r0 + 15) {
            const LAS unsigned char* sb = lds + (t & 1) * STG;
            const bool far = (r0 - (k0 + 63)) >= 113;
            u32x4 pb[2][2];
#pragma unroll
            for (int mp = 0; mp < 2; ++mp) {
                const float cinit = (far ? (mp ? c31b : c31a) : 0.f) - mref[mp];
                f32x4 s[4];
#pragma unroll
                for (int i = 0; i < 4; ++i) { s[i] = (f32x4){cinit, cinit, cinit, cinit};
#pragma unroll
                    for (int ks = 0; ks < 2; ++ks) { const bf16x8 kf = *(const LAS bf16x8*)(sb + mp * K_BYTES + (16 * i + li) * KP + (32 * ks + 8 * Q) * 2);
                        s[i] = __builtin_amdgcn_mfma_f32_16x16x32_bf16(kf, qf[mp][ks], s[i], 0, 0, 0); } }
                if (!far) {
                    const LAS float* lut = (const LAS float*)(lds + LUT) + mp * 128;
#pragma unroll
                    for (int i = 0; i < 4; ++i)
#pragma unroll
                        for (int r = 0; r < 4; ++r) { const int dist = (r0 + li) - (k0 + 16 * i + 4 * Q + r); const int di = dist < 0 ? 0 : (dist > 127 ? 127 : dist);
                            const float v = s[i][r] + lut[di]; s[i][r] = dist < 0 ? NEG : v; }
                }
                float mx = fmaxf(fmaxf(fmaxf(s[0][0], s[0][1]), fmaxf(s[0][2], s[0][3])), fmaxf(fmaxf(s[1][0], s[1][1]), fmaxf(s[1][2], s[1][3])));
                mx = fmaxf(mx, fmaxf(fmaxf(fmaxf(s[2][0], s[2][1]), fmaxf(s[2][2], s[2][3])), fmaxf(fmaxf(s[3][0], s[3][1]), fmaxf(s[3][2], s[3][3]))));
                mx = gmax4(mx);
                const float delta = (t == 0) ? mx : fmaxf(mx, 0.f);
                if (__any(delta != 0.f)) {
                    const float alpha = __builtin_amdgcn_exp2f(-delta); mref[mp] += delta;
#pragma unroll
                    for (int i = 0; i < 4; ++i) s[i] = s[i] - delta;
#pragma unroll
                    for (int vt = 0; vt < 8; ++vt) OT[mp][vt] = OT[mp][vt] * alpha;
                    LT[mp] = LT[mp] * alpha; }
#pragma unroll
                for (int i = 0; i < 4; ++i)
#pragma unroll
                    for (int r = 0; r < 4; ++r) s[i][r] = __builtin_amdgcn_exp2f(s[i][r]);
                pb[mp][0] = (u32x4){pkbf(s[0][0], s[0][1]), pkbf(s[0][2], s[0][3]), pkbf(s[1][0], s[1][1]), pkbf(s[1][2], s[1][3])};
                pb[mp][1] = (u32x4){pkbf(s[2][0], s[2][1]), pkbf(s[2][2], s[2][3]), pkbf(s[3][0], s[3][1]), pkbf(s[3][2], s[3][3])};
                LT[mp] = __builtin_amdgcn_mfma_f32_16x16x32_bf16(ones, __builtin_bit_cast(bf16x8, pb[mp][0]), LT[mp], 0, 0, 0);
                LT[mp] = __builtin_amdgcn_mfma_f32_16x16x32_bf16(ones, __builtin_bit_cast(bf16x8, pb[mp][1]), LT[mp], 0, 0, 0);
            }
            const LAS unsigned char* vb = sb + 2 * K_BYTES;
#pragma unroll
            for (int T = 0; T < 2; ++T)
#pragma unroll
                for (int vt = 0; vt < 8; ++vt) { const LAS unsigned char* vp = vb + (32 * T + 4 * Q + (li >> 2)) * VP + (16 * vt + 4 * (li & 3)) * 2;
                    const s16x4 lo = trd(vp), hi = trd(vp + 16 * VP); const bf16x8 vf = (bf16x8){lo[0], lo[1], lo[2], lo[3], hi[0], hi[1], hi[2], hi[3]};
                    OT[0][vt] = __builtin_amdgcn_mfma_f32_16x16x32_bf16(vf, __builtin_bit_cast(bf16x8, pb[0][T]), OT[0][vt], 0, 0, 0);
                    OT[1][vt] = __builtin_amdgcn_mfma_f32_16x16x32_bf16(vf, __builtin_bit_cast(bf16x8, pb[1][T]), OT[1][vt], 0, 0, 0); }
        }
        if (t + 1 < NT) AT_STORE((t + 1) & 1);
        HG_LBAR();
    }
#undef AT_LOAD
#undef AT_STORE
    const float l0 = LT[0][0], l1 = LT[1][0];
    const float i0 = 1.0f / l0, i1 = lam / l1; float ss = 0.f;
#pragma unroll
    for (int vt = 0; vt < 8; ++vt) { OT[0][vt] = OT[0][vt] * i0 - OT[1][vt] * i1; ss += (OT[0][vt][0] * OT[0][vt][0] + OT[0][vt][1] * OT[0][vt][1]) + (OT[0][vt][2] * OT[0][vt][2] + OT[0][vt][3] * OT[0][vt][3]); }
    ss += __shfl_xor(ss, 16); ss += __shfl_xor(ss, 32);
    const float rstd = (1.0f - LAM_INIT) / sqrtf(ss * (1.0f / DADV) + RMS_EPS);
    bf16* op = ODA + (rbase + r0 + li) * OPITCH + h * DADV + 4 * Q;
#pragma unroll
    for (int vt = 0; vt < 8; ++vt) { const f32x4 wv = *(const f32x4*)(a.in[17] + 16 * vt + 4 * Q); const f32x4 o = OT[0][vt] * rstd * wv;
        *(u32x2*)(op + 16 * vt) = (u32x2){pkbf(o[0], o[1]), pkbf(o[2], o[3])}; }
}
}
namespace dc {
typedef short bf16x8 __attribute__((ext_vector_type(8)));
typedef short s16x4 __attribute__((ext_vector_type(4)));
typedef float f32x4 __attribute__((ext_vector_type(4)));
typedef unsigned u32x2 __attribute__((ext_vector_type(2)));
typedef unsigned u32x4 __attribute__((ext_vector_type(4)));
constexpr int NPG = 2, NSPLIT = NPAGES / NPG;
constexpr int VP = 288, WREG = 32 * VP, FLAG = 8 * WREG, LDS_END = FLAG + 64;
constexpr size_t PM_OFF = 0, PL_OFF = (size_t)SB * NH * 16 * NSPLIT * 4, PO_OFF = 2 * PL_OFF, PO_BYTES = (size_t)SB * NSPLIT * NH * 16 * 128 * 4;
static_assert(WS_DEC + PO_OFF + PO_BYTES <= WS_END && LDS_END <= 131072, "decode maps");
constexpr float NEG = -1e30f;
using hg::pkbf; using hg::trd;
__device__ __forceinline__ f32x4 ldnt(const float* p) { return __builtin_nontemporal_load((const f32x4*)p); }

__device__ __forceinline__ void combine_task(LAS unsigned char* lds, const Args& a, gu32* cnt, int s, int h, float lam) {
    int tid = threadIdx.x; asm volatile("" : "+v"(tid));
    const int lane = tid & 63, w = __builtin_amdgcn_readfirstlane(tid >> 6), Q = lane >> 4, li = lane & 15, mp = li >> 3, j = li & 7;
    if (tid < 64) { unsigned sp = 0; while ((unsigned)__builtin_amdgcn_readfirstlane((int)__hip_atomic_load(cnt + 64 * s, RLX_AGENT)) < (unsigned)NSPLIT) { __builtin_amdgcn_s_sleep(2); if (++sp > (1u << 22)) break; }
        __builtin_amdgcn_fence(__ATOMIC_ACQUIRE, "agent"); asm volatile("s_waitcnt vmcnt(0)" ::: "memory"); }
    __syncthreads();
    const bf16* U = (const bf16*)(a.ws + WS_U); bf16* ODA = (bf16*)(a.ws + WS_ODA);
    const float* PM = (const float*)(a.ws + WS_DEC + PM_OFF) + (size_t)((s * NH + h) * 16 + li) * NSPLIT; const float* PLs = (const float*)(a.ws + WS_DEC + PL_OFF) + (size_t)((s * NH + h) * 16 + li) * NSPLIT;
    const float* PO = (const float*)(a.ws + WS_DEC + PO_OFF);
    float sn[8];
    { f32x4 qv[16]; const bf16* qp = U + (size_t)(MP + s * SL + j) * NIN + C_DQ + (mp * 8 + h) * 64;
#pragma unroll
      for (int c = 0; c < 8; ++c) { const u32x4 t = *(const u32x4*)(qp + 8 * c); qv[2 * c] = (f32x4){hg::lo2f(t.x), hg::hi2f(t.x), hg::lo2f(t.y), hg::hi2f(t.y)}; qv[2 * c + 1] = (f32x4){hg::lo2f(t.z), hg::hi2f(t.z), hg::lo2f(t.w), hg::hi2f(t.w)}; }
#pragma unroll
      for (int jj = 0; jj < 8; ++jj) { const float* kp = a.out + O_KS + (size_t)(s * SL + jj) * 1024 + (mp * 8 + h) * 64; float sc = 0.f;
#pragma unroll
          for (int c = 0; c < 16; ++c) { const f32x4 kv = *(const f32x4*)(kp + 4 * c); sc += (qv[c][0] * kv[0] + qv[c][1] * kv[1]) + (qv[c][2] * kv[2] + qv[c][3] * kv[3]); }
          const int dist = j - jj; sc += a.in[18][(dist < 0 ? 0 : dist) * 16 + mp * 8 + h] * LOG2E;
          sn[jj] = dist < 0 ? NEG : sc; __builtin_amdgcn_sched_barrier(0); } }
    float mstar = NEG;
#pragma unroll
    for (int c = 0; c < NSPLIT / 4; ++c) { const f32x4 t = *(const f32x4*)(PM + 4 * c); mstar = fmaxf(mstar, fmaxf(fmaxf(t[0], t[1]), fmaxf(t[2], t[3]))); }
#pragma unroll
    for (int jj = 0; jj < 8; ++jj) mstar = fmaxf(mstar, sn[jj]);
    f32x4 acc[8]; float lsum = 0.f;
#pragma unroll
    for (int vt = 0; vt < 8; ++vt) acc[vt] = (f32x4){0.f, 0.f, 0.f, 0.f};
    static_assert(NSPLIT == 64, "8 waves x 8 splits");
#pragma unroll 1
    for (int c = 0; c < 4; ++c) { const float m0 = PM[8 * w + 2 * c], m1 = PM[8 * w + 2 * c + 1], l0 = PLs[8 * w + 2 * c], l1 = PLs[8 * w + 2 * c + 1];
        f32x4 ov[2][8];
#pragma unroll
        for (int e = 0; e < 2; ++e) { const float* op = PO + ((((size_t)s * NSPLIT + (8 * w + 2 * c + e)) * NH + h) * 16 + li) * 128 + 4 * Q;
#pragma unroll
            for (int vt = 0; vt < 8; ++vt) ov[e][vt] = *(const f32x4*)(op + 16 * vt); }
        const float w0 = __builtin_amdgcn_exp2f(m0 - mstar), w1 = __builtin_amdgcn_exp2f(m1 - mstar); lsum += w0 * l0 + w1 * l1;
#pragma unroll
        for (int vt = 0; vt < 8; ++vt) acc[vt] += ov[0][vt] * w0 + ov[1][vt] * w1; }
    if (w == 0) {
#pragma unroll
        for (int jj = 0; jj < 8; ++jj) { const float p = __builtin_amdgcn_exp2f(sn[jj] - mstar); lsum += p; const float* vp = a.out + O_VS + (size_t)(s * SL + jj) * 1024 + h * 128 + 4 * Q;
#pragma unroll
            for (int vt = 0; vt < 8; ++vt) acc[vt] += *(const f32x4*)(vp + 16 * vt) * p; } }
    LAS float* P = (LAS float*)lds;
#pragma unroll
    for (int vt = 0; vt < 8; ++vt)
#pragma unroll
        for (int r = 0; r < 4; ++r) P[(w * 33 + vt * 4 + r) * 64 + lane] = acc[vt][r];
    P[(w * 33 + 32) * 64 + lane] = lsum;
    HG_LBAR();
    if (w == 0) {
        lsum = 0.f;
#pragma unroll
        for (int ww = 0; ww < 8; ++ww) lsum += P[(ww * 33 + 32) * 64 + lane];
        const float sc = (mp ? -lam : 1.0f) / lsum; float ss = 0.f;
#pragma unroll
        for (int vt = 0; vt < 8; ++vt) { f32x4 o;
#pragma unroll
            for (int r = 0; r < 4; ++r) { float t = 0.f;
#pragma unroll
                for (int ww = 0; ww < 8; ++ww) t += P[(ww * 33 + vt * 4 + r) * 64 + lane];
                t *= sc; t += __shfl_xor(t, 8); o[r] = t; }
            acc[vt] = o; ss += (o[0] * o[0] + o[1] * o[1]) + (o[2] * o[2] + o[3] * o[3]); }
        ss += __shfl_xor(ss, 16); ss += __shfl_xor(ss, 32);
        const float rstd = (1.0f - LAM_INIT) / sqrtf(ss * (1.0f / DADV) + RMS_EPS);
        if (mp == 0) { bf16* op = ODA + (size_t)(MP + s * SL + j) * OPITCH + h * DADV + 4 * Q;
#pragma unroll
            for (int vt = 0; vt < 8; ++vt) { const f32x4 wv = *(const f32x4*)(a.in[17] + 16 * vt + 4 * Q); const f32x4 o = acc[vt] * rstd * wv; *(u32x2*)(op + 16 * vt) = (u32x2){pkbf(o[0], o[1]), pkbf(o[2], o[3])}; } }
    }
    HG_LBAR();
}

__device__ __forceinline__ void unit(LAS unsigned char* lds, const Args& a, gu32* cnt, int s, int g, float lam) {
    int tid = threadIdx.x; asm volatile("" : "+v"(tid));
    const int lane = tid & 63, h = __builtin_amdgcn_readfirstlane(tid >> 6), Q = lane >> 4, li = lane & 15, mp = li >> 3, j = li & 7;
    const bf16* U = (const bf16*)(a.ws + WS_U);
    LAS unsigned char* wreg = lds + h * WREG;
    const float c31 = a.in[18][31 * 16 + mp * 8 + h] * LOG2E;
    bf16x8 qf[2];
#pragma unroll
    for (int ks = 0; ks < 2; ++ks) qf[ks] = *(const bf16x8*)(U + (size_t)(MP + s * SL + j) * NIN + C_DQ + (mp * 8 + h) * 64 + 32 * ks + 8 * Q);
    f32x4 OT[8];
#pragma unroll
    for (int vt = 0; vt < 8; ++vt) OT[vt] = (f32x4){0.f, 0.f, 0.f, 0.f};
    float mrun = NEG, lrun = 0.f;
#pragma unroll 1
    for (int pg = 0; pg < NPG; ++pg) {
        const int lp = g * NPG + pg, page = a.page_table[s * NPAGES + lp];
        const __amdgpu_buffer_rsrc_t krs = __builtin_amdgcn_make_buffer_rsrc((void*)(a.in[2] + (size_t)page * PAGE * 1024), 0, PAGE * 1024 * 4, 0x00020000);
        const __amdgpu_buffer_rsrc_t vrs = __builtin_amdgcn_make_buffer_rsrc((void*)(a.in[3] + (size_t)page * PAGE * 1024), 0, PAGE * 1024 * 4, 0x00020000);
        const int kvo = ((lane >> 4) * 1024 + h * 64 + (lane & 15) * 4) * 4;
        const int vvo = ((lane >> 5) * 1024 + h * 128 + (lane & 31) * 4) * 4;
        f32x4 kr[8];
#define DC_LD(rs, vo, so) __builtin_bit_cast(f32x4, __builtin_amdgcn_raw_buffer_load_b128(rs, vo, so, 0))
#define DC_KLOAD(dst, i) do { const int so_ = 16 * (i) * 4096; \
            dst[0] = DC_LD(krs, kvo, so_); dst[1] = DC_LD(krs, kvo, so_ + 4 * 4096); dst[2] = DC_LD(krs, kvo, so_ + 8 * 4096); dst[3] = DC_LD(krs, kvo, so_ + 12 * 4096); \
            dst[4] = DC_LD(krs, kvo, so_ + 2048); dst[5] = DC_LD(krs, kvo, so_ + 4 * 4096 + 2048); dst[6] = DC_LD(krs, kvo, so_ + 8 * 4096 + 2048); dst[7] = DC_LD(krs, kvo, so_ + 12 * 4096 + 2048); } while (0)
        constexpr int KRP = 144, KMAP = 16 * KRP, KSLAB = 2 * KMAP; static_assert(2 * KSLAB <= WREG, "K slabs inside the wave's V stage");
        LAS unsigned char* kwr = wreg + (lane >> 4) * KRP + (lane & 15) * 8; const LAS unsigned char* kfr = wreg + li * KRP + 16 * Q;
#define DC_KPARK(src, i) do { _Pragma("unroll") for (int n_ = 0; n_ < 8; ++n_) *(LAS u32x2*)(kwr + ((i) & 1) * KSLAB + (n_ >> 2) * KMAP + 4 * (n_ & 3) * KRP) = (u32x2){pkbf(src[n_][0], src[n_][1]), pkbf(src[n_][2], src[n_][3])}; } while (0)
#define DC_KF(i, m, ks) (*(const LAS bf16x8*)(kfr + ((i) & 1) * KSLAB + (m) * KMAP + 64 * (ks)))
        f32x4 S[8];
        DC_KLOAD(kr, 0);
#pragma unroll
        for (int i = 0; i < 8; ++i) {
            DC_KPARK(kr, i);
            if (i + 1 < 8) DC_KLOAD(kr, i + 1);
            asm volatile("" ::: "memory");
            const bf16x8 k00 = DC_KF(i, 0, 0), k01 = DC_KF(i, 0, 1), k10 = DC_KF(i, 1, 0), k11 = DC_KF(i, 1, 1);
            const f32x4 z = (f32x4){0.f, 0.f, 0.f, 0.f};
            f32x4 t1 = __builtin_amdgcn_mfma_f32_16x16x32_bf16(k00, qf[0], z, 0, 0, 0); t1 = __builtin_amdgcn_mfma_f32_16x16x32_bf16(k01, qf[1], t1, 0, 0, 0);
            f32x4 t2 = __builtin_amdgcn_mfma_f32_16x16x32_bf16(k10, qf[0], z, 0, 0, 0); t2 = __builtin_amdgcn_mfma_f32_16x16x32_bf16(k11, qf[1], t2, 0, 0, 0);
            S[i] = mp ? t2 : t1;
            __builtin_amdgcn_sched_barrier(0);
        }
        f32x4 vr[16];
#define DC_VLOAD(T) do { _Pragma("unroll") for (int n_ = 0; n_ < 16; ++n_) vr[n_] = DC_LD(vrs, vvo, (32 * (T) + 2 * n_) * 4096); } while (0)
        DC_VLOAD(0);
        if (lp == NPAGES - 1) {
#pragma unroll
            for (int i = 0; i < 8; ++i)
#pragma unroll
                for (int r = 0; r < 4; ++r) { const int dist = PAST + j - (lp * PAGE + 16 * i + 4 * Q + r); S[i][r] += a.in[18][t5_bucket(dist) * 16 + mp * 8 + h] * LOG2E; }
        } else {
#pragma unroll
            for (int i = 0; i < 8; ++i) S[i] = S[i] + c31;
        }
        float mx = NEG;
#pragma unroll
        for (int i = 0; i < 8; ++i) mx = fmaxf(mx, fmaxf(fmaxf(S[i][0], S[i][1]), fmaxf(S[i][2], S[i][3])));
        mx = fmaxf(mx, __shfl_xor(mx, 16)); mx = fmaxf(mx, __shfl_xor(mx, 32));
        const float mn = fmaxf(mrun, mx), alpha = __builtin_amdgcn_exp2f(mrun - mn); mrun = mn;
        float ps = 0.f;
#pragma unroll
        for (int i = 0; i < 8; ++i)
#pragma unroll
            for (int r = 0; r < 4; ++r) { S[i][r] = __builtin_amdgcn_exp2f(S[i][r] - mn); ps += S[i][r]; }
        lrun = lrun * alpha + ps;
#pragma unroll
        for (int vt = 0; vt < 8; ++vt) OT[vt] = OT[vt] * alpha;
#pragma unroll
        for (int T = 0; T < 4; ++T) {
#pragma unroll
            for (int n = 0; n < 16; ++n) *(LAS u32x2*)(wreg + (2 * n + (lane >> 5)) * VP + (lane & 31) * 8) = (u32x2){pkbf(vr[n][0], vr[n][1]), pkbf(vr[n][2], vr[n][3])};
            if (T + 1 < 4) DC_VLOAD(T + 1);
            asm volatile("s_waitcnt lgkmcnt(0)" ::: "memory");
            const bf16x8 pb = __builtin_bit_cast(bf16x8, (u32x4){pkbf(S[2 * T][0], S[2 * T][1]), pkbf(S[2 * T][2], S[2 * T][3]), pkbf(S[2 * T + 1][0], S[2 * T + 1][1]), pkbf(S[2 * T + 1][2], S[2 * T + 1][3])});
#pragma unroll
            for (int vt = 0; vt < 8; ++vt) { const LAS unsigned char* vp = wreg + (4 * Q + (li >> 2)) * VP + (16 * vt + 4 * (li & 3)) * 2;
                const s16x4 lo = trd(vp), hi = trd(vp + 16 * VP); const bf16x8 vf = (bf16x8){lo[0], lo[1], lo[2], lo[3], hi[0], hi[1], hi[2], hi[3]};
                OT[vt] = __builtin_amdgcn_mfma_f32_16x16x32_bf16(vf, pb, OT[vt], 0, 0, 0); if ((vt & 3) == 3) __builtin_amdgcn_sched_barrier(0); }
            asm volatile("s_waitcnt lgkmcnt(0)" ::: "memory");
            __builtin_amdgcn_sched_barrier(0);
        }
#undef DC_KLOAD
#undef DC_LD
#undef DC_KF
#undef DC_KPARK
#undef DC_VLOAD
    }
    lrun += __shfl_xor(lrun, 16); lrun += __shfl_xor(lrun, 32);
    if (Q == 0) { const size_t o = (size_t)((s * NH + h) * 16 + li) * NSPLIT + g;
        __hip_atomic_store((gu32*)(a.ws + WS_DEC + PM_OFF) + o, __float_as_uint(mrun), RLX_AGENT); __hip_atomic_store((gu32*)(a.ws + WS_DEC + PL_OFF) + o, __float_as_uint(lrun), RLX_AGENT); }
    { const __amdgpu_buffer_rsrc_t rs = __builtin_amdgcn_make_buffer_rsrc(a.ws + WS_DEC + PO_OFF, 0, (int)PO_BYTES, 0x00020000);
      const unsigned off = (unsigned)((((((size_t)s * NSPLIT + g) * NH + h) * 16 + li) * 128 + 4 * Q) * 4);
#pragma unroll
      for (int vt = 0; vt < 8; ++vt) __builtin_amdgcn_raw_buffer_store_b128(__builtin_bit_cast(u32x4, OT[vt]), rs, off + 64 * vt, 0, 16); }
    asm volatile("s_waitcnt vmcnt(0)" ::: "memory");
    __syncthreads();
    if (tid == 0) (void)__hip_atomic_fetch_add(cnt + 64 * s, 1u, RLX_AGENT);
}
}
namespace th {
typedef short bf16x8 __attribute__((ext_vector_type(8)));
typedef float f32x4 __attribute__((ext_vector_type(4)));
typedef unsigned u32x4_t __attribute__((ext_vector_type(4)));
template <int K>
__device__ __forceinline__ void stream_gemm(LAS unsigned char* slab, const bf16* X, const bf16* W, int ld, int row0, int n0, int w, int lane, f32x4 (&acc)[2]) {
    constexpr int NG = K / 128, RP = 272; static_assert(NG * 128 == K, "K in groups of 128");
    const int r = lane >> 4, c = lane & 15, li = lane & 15, Q = lane >> 4;
    const GAS unsigned char* wb = (const GAS unsigned char*)(W + (size_t)(n0 + r) * ld) + 16 * c;
    const GAS unsigned char* xb = (const GAS unsigned char*)(X + (size_t)(row0 + r) * ld) + 16 * c;
    const size_t rs4 = (size_t)ld * 8;
    LAS unsigned char* wr = slab + r * RP + 16 * c;
    const LAS unsigned char* fa = slab + li * RP + 16 * Q;
    u32x4_t t[12];
    int g = w;
    if (g < NG) {
#pragma unroll
        for (int j = 0; j < 12; ++j) t[j] = *(const GAS u32x4_t*)((j < 4 ? wb + j * rs4 : xb + (j - 4) * rs4) + (size_t)g * 256);
    }
#pragma unroll 1
    for (; g < NG; g += 8) {
#pragma unroll
        for (int j = 0; j < 12; ++j) *(LAS u32x4_t*)(wr + 4 * j * RP) = t[j];
        if (g + 8 < NG) {
#pragma unroll
            for (int j = 0; j < 12; ++j) t[j] = *(const GAS u32x4_t*)((j < 4 ? wb + j * rs4 : xb + (j - 4) * rs4) + (size_t)(g + 8) * 256);
        }
        asm volatile("s_waitcnt lgkmcnt(0)" ::: "memory");
        bf16x8 af[4], b0[4], b1[4];
#pragma unroll
        for (int s = 0; s < 4; ++s) { af[s] = *(const LAS bf16x8*)(fa + 64 * s); b0[s] = *(const LAS bf16x8*)(fa + 16 * RP + 64 * s); b1[s] = *(const LAS bf16x8*)(fa + 32 * RP + 64 * s); }
#pragma unroll
        for (int s = 0; s < 4; ++s) { acc[0] = __builtin_amdgcn_mfma_f32_16x16x32_bf16(af[s], b0[s], acc[0], 0, 0, 0); acc[1] = __builtin_amdgcn_mfma_f32_16x16x32_bf16(af[s], b1[s], acc[1], 0, 0, 0); }
        asm volatile("s_waitcnt lgkmcnt(0)" ::: "memory");
    }
}
template <int K, int NACC, class Epi>
__device__ __forceinline__ void tile(LAS unsigned char* lds, const bf16* X1, const bf16* W1, const bf16* X2, const bf16* W2, int row0, int n0, const Epi& E, int ld = K) {
    int tid = threadIdx.x; asm volatile("" : "+v"(tid));
    const int lane = tid & 63, w = __builtin_amdgcn_readfirstlane(tid >> 6), li = lane & 15, Q = lane >> 4;
    f32x4 acc[NACC][2];
#pragma unroll
    for (int g = 0; g < NACC; ++g)
#pragma unroll
        for (int mt = 0; mt < 2; ++mt) acc[g][mt] = (f32x4){0.f, 0.f, 0.f, 0.f};
    LAS unsigned char* slab = lds + w * (48 * 272);
    stream_gemm<K>(slab, X1, W1, ld, row0, n0, w, lane, acc[0]);
    if constexpr (NACC == 2) stream_gemm<K>(slab, X2, W2, ld, row0, n0, w, lane, acc[1]);
    HG_LBAR();
    LAS float* P = (LAS float*)lds;
#pragma unroll
    for (int g = 0; g < NACC; ++g)
#pragma unroll
        for (int mt = 0; mt < 2; ++mt)
#pragma unroll
            for (int r = 0; r < 4; ++r) P[(w * NACC * 8 + g * 8 + mt * 4 + r) * 64 + lane] = acc[g][mt][r];
    HG_LBAR();
    const int mt = w >> 2, r0 = w & 3;
    float v[NACC];
#pragma unroll
    for (int g = 0; g < NACC; ++g) { float s = 0.f;
#pragma unroll
        for (int ww = 0; ww < 8; ++ww) s += P[(ww * NACC * 8 + g * 8 + mt * 4 + r0) * 64 + lane];
        v[g] = s; }
    E(row0 + 16 * mt + li, n0 + 4 * Q + r0, v[0], v[NACC - 1]);
    HG_LBAR();
}
}
constexpr int N_PHASES = 9;
#if 0
#define PROBE_PHASE_UNUSED -1
#endif
#define REP(k) for (int rp_ = 0; rp_ < ((PROBE_PHASE == (k)) ? 2 : 1); ++rp_)
#define PROBE_MUL(k) ((PROBE_PHASE == (k) || PROBE_PHASE == 29) ? 2 : 1)
#define REPBAR(k) do { if (PROBE_PHASE == (k) && rp_ == 0) GRID_BAR(); } while (0)
__global__ void __launch_bounds__(NWAVES * 64, 2) mk_fwd(Args args) {
    extern __shared__ __attribute__((aligned(16))) unsigned char lds[];
    Frame F;
    F.lds = (LAS unsigned char*)lds; F.MISC = (volatile LAS unsigned*)(F.lds + MISC_OFF);
    F.tid = threadIdx.x; F.lane = F.tid & 63; F.wave = __builtin_amdgcn_readfirstlane(F.tid >> 6);
    F.G = gridDim.x; { const int bx = blockIdx.x; F.vcu = (F.G % 8 == 0) ? (bx % 8) * (F.G / 8) + bx / 8 : bx; }
    unsigned char* ws = args.ws;
    F.ctl = (gu32*)(ws + WS_CTL);
    for (int u = F.tid; u < (LDS_BYTES - LDSCTL_OFF) / 4; u += NWAVES * 64) ((LAS unsigned*)(F.lds + LDSCTL_OFF))[u] = 0u;
    __syncthreads();
    const int lo = args.ph_lo, hi = args.ph_hi;
    XcdBarrier bar = xcd_barrier_post((unsigned*)(F.ctl + CW_BAR) + lo * XCD_BAR_WORDS, F.MISC + 8);
#define IN(k) (lo <= (k) && (k) < hi)
#define BOTH(k) (IN(k) && IN((k) + 1))
#define GRID_BAR() xcd_barrier(bar)
    if (IN(0)) REP(0) { p0_prologue(F, args); REPBAR(0); if (BOTH(0)) GRID_BAR(); }
    if (IN(1)) REP(1) {
        pg8::Gemm g{(const bf16*)(ws + WS_XN), (const bf16*)(ws + WS_WIN), MT, NIN, DM}; pg8::StaticOrder S; S.init(MT, NIN, F.G, (int)blockIdx.x);
        pg8::EpiInProj E{(bf16*)(ws + WS_U), (float*)(ws + WS_G), args.out + O_KP, args.out + O_VP, args.out + O_KS, args.out + O_VS, args.in[11], NIN, MP, MREAL, QSCALE};
        pg8::gemm_phase<pg8::EpiInProj, pg8::StaticOrder, true, true>(F.lds + RING_OFF, g, S, E);
        if (rp_ == 0) convert_late(F, args, F.ctl + CW_Q + 32);
        REPBAR(1); if (BOTH(1)) GRID_BAR();
    }
    if (PROBE_PHASE == 30) { for (int i = 0; i < 16; ++i) GRID_BAR(); }
    if (IN(2)) REP(2) {
        const float lam = da_lambda(args);
#define QPOP(word) ({ if (F.tid == 0) F.MISC[0] = __hip_atomic_fetch_add(F.ctl + (word), 1u, RLX_AGENT); __syncthreads(); const int u_ = __builtin_amdgcn_readfirstlane((int)F.MISC[0]); __syncthreads(); u_; })
        const bool roleA = (((blockIdx.x >> 3) & 1) == 0) || F.G < 128;
        if ((args.p2mask & 1) && roleA) for (;;) { const int u = QPOP(CW_Q + 256 * rp_); if (u >= PB * NH * PROBE_MUL(20)) break; hg::prompt_unit(F.lds + RING_OFF, args, (u % (PB * NH)) / NH, u % NH); }
        if ((args.p2mask & 8) && roleA) for (;;) { const int u = QPOP(CW_Q + 192 + 256 * rp_); if (u >= SB * NH) break; hg::sample_unit(F.lds + RING_OFF, args, u / NH, u % NH); }
        if ((args.p2mask & 2) && ((blockIdx.x >> 3) & 1)) for (;;) { const int u = QPOP(CW_Q + 64 + 256 * rp_); if (u >= SB * dc::NSPLIT * PROBE_MUL(21)) break; const int uu = u % (SB * dc::NSPLIT), rr = u / (SB * dc::NSPLIT);
                   dc::unit(F.lds + RING_OFF, args, F.ctl + CW_DCNT + 512 * (rp_ + rr), uu / dc::NSPLIT, uu % dc::NSPLIT, lam); }
        if (args.p2mask & 4) for (;;) { const int u = QPOP(CW_Q + 128 + 256 * rp_); if (u >= PB * DAH * 16 * PROBE_MUL(22)) break; const int uu = u % (PB * DAH * 16), qb = 15 - (uu >> 5), bh = uu & 31; at::prompt_unit(F.lds + RING_OFF, args, bh / DAH, bh % DAH, qb, lam); }
        if (args.p2mask & 2) for (;;) { const int u = QPOP(CW_Q + 64 + 256 * rp_); if (u >= SB * dc::NSPLIT * PROBE_MUL(21)) break; const int uu = u % (SB * dc::NSPLIT), rr = u / (SB * dc::NSPLIT);
                   dc::unit(F.lds + RING_OFF, args, F.ctl + CW_DCNT + 512 * (rp_ + rr), uu / dc::NSPLIT, uu % dc::NSPLIT, lam); }
        if (args.p2mask & 2) for (;;) { const int u = QPOP(CW_Q + 224 + 256 * rp_); if (u >= SB * NH * PROBE_MUL(21)) break; const int uu = u % (SB * NH), rr = u / (SB * NH);
                   dc::combine_task(F.lds + RING_OFF, args, F.ctl + CW_DCNT + 512 * (rp_ + rr), uu / NH, uu % NH, lam); }
#undef QPOP
        REPBAR(2); if (BOTH(2)) GRID_BAR();
    }
    if (IN(3)) REP(3) {
        { pg8::Gemm g{(const bf16*)(ws + WS_OHG), (const bf16*)(ws + WS_WBH), MP, DM, OPITCH}; pg8::StaticOrder S; S.init(MP, DM, F.G, (int)blockIdx.x, 4);
          pg8::EpiBranchCat E{(const bf16*)(ws + WS_U) + C_GHG, (const bf16*)(ws + WS_U) + C_GDA, NIN, (bf16*)(ws + WS_MIX)};
          pg8::gemm_phase<pg8::EpiBranchCat, pg8::StaticOrder, true, true>(F.lds + RING_OFF, g, S, E); }
        for (int tn = (int)blockIdx.x; tn < 2 * (DM / 16); tn += F.G) {
            const bf16* Ub = (const bf16*)(ws + WS_U); bf16* MIX = (bf16*)(ws + WS_MIX);
            auto E = [=](int tok, int n, float a, float b) { const size_t row = (size_t)(MP + tok);
                MIX[row * DM + n] = (bf16)f2bf(bf2f(Ub[row * NIN + C_GHG + n]) * a + bf2f(Ub[row * NIN + C_GDA + n]) * b); };
            th::tile<1024, 2>(F.lds + RING_OFF, (const bf16*)(ws + WS_OHG) + (size_t)MP * OPITCH, (const bf16*)(ws + WS_WBH), (const bf16*)(ws + WS_ODA) + (size_t)MP * OPITCH, (const bf16*)(ws + WS_WBD), 32 * (tn & 1), 16 * (tn >> 1), E, OPITCH);
        }
        REPBAR(3); if (BOTH(3)) GRID_BAR();
    }
    if (IN(4)) REP(4) {
        pg8::Gemm g{(const bf16*)(ws + WS_MIX), (const bf16*)(ws + WS_WOUT), MP, DM, DM}; pg8::StaticOrder S; S.init(MP, DM, F.G, (int)blockIdx.x, 4);
        pg8::EpiBf16Plain E{(bf16*)(ws + WS_Y1), DM};
        pg8::gemm_phase<pg8::EpiBf16Plain, pg8::StaticOrder, true, true>(F.lds + RING_OFF, g, S, E);
        for (int tn = (int)blockIdx.x; tn < 2 * (DM / 16); tn += F.G) {
            bf16* Y = (bf16*)(ws + WS_Y1);
            auto Et = [=](int tok, int n, float a, float) { Y[(size_t)(MP + tok) * DM + n] = (bf16)f2bf(a); };
            th::tile<DM, 1>(F.lds + RING_OFF, (const bf16*)(ws + WS_MIX) + (size_t)MP * DM, (const bf16*)(ws + WS_WOUT), nullptr, nullptr, 32 * (tn & 1), 16 * (tn >> 1), Et);
        }
        REPBAR(4); if (BOTH(4)) GRID_BAR();
    }
    if (IN(5)) REP(5) { row_pass1(F, args); REPBAR(5); if (BOTH(5)) GRID_BAR(); }
    if (IN(6)) REP(6) {
        pg8::Gemm g{(const bf16*)(ws + WS_XN2), (const bf16*)(ws + WS_WUP), MT, NIN, DM}; pg8::StaticOrder S; S.init(MT, NIN, F.G, (int)blockIdx.x);
        pg8::EpiSwiGLU E{(bf16*)(ws + WS_HID), DFF};
        pg8::gemm_phase<pg8::EpiSwiGLU, pg8::StaticOrder, true, true>(F.lds + RING_OFF, g, S, E);
        if (rp_ == 0) convert_dn(F, args, F.ctl + CW_Q + 36);
        REPBAR(6); if (BOTH(6)) GRID_BAR();
    }
    if (IN(7)) REP(7) {
        pg8::Gemm g{(const bf16*)(ws + WS_HID), (const bf16*)(ws + WS_WDN), MP, DM, DFF}; pg8::StaticOrder S; S.init(MP, DM, F.G, (int)blockIdx.x, 4);
        pg8::EpiBf16Plain E{(bf16*)(ws + WS_Y2), DM};
        pg8::gemm_phase<pg8::EpiBf16Plain, pg8::StaticOrder, true, true>(F.lds + RING_OFF, g, S, E);
        for (int tn = (int)blockIdx.x; tn < 2 * (DM / 16); tn += F.G) {
            bf16* Y = (bf16*)(ws + WS_Y2);
            auto Et = [=](int tok, int n, float a, float) { Y[(size_t)(MP + tok) * DM + n] = (bf16)f2bf(a); };
            th::tile<DFF, 1>(F.lds + RING_OFF, (const bf16*)(ws + WS_HID) + (size_t)MP * DFF, (const bf16*)(ws + WS_WDN), nullptr, nullptr, 32 * (tn & 1), 16 * (tn >> 1), Et);
        }
        REPBAR(7); if (BOTH(7)) GRID_BAR();
    }
    if (IN(8)) REP(8) { row_pass2(F, args); REPBAR(8); }
#undef IN
#undef BOTH
#undef GRID_BAR
}
extern "C" void kernel_launch(void* const* d_in, const int* in_sizes, int n_in, void* d_out, int out_size, void* d_ws, size_t ws_size, hipStream_t stream) {
    static int grid = 0;
    if (grid == 0) {
        if (n_in != 24 || in_sizes[0] != MP * DM || (size_t)out_size != O_END || ws_size < WS_END) { fprintf(stderr, "kernel_launch: unexpected shapes (n_in %d, in0 %d, out %d, ws %zu); nothing launched\n", n_in, n_in > 0 ? in_sizes[0] : -1, out_size, ws_size); grid = -1; return; }
        int dev = 0, cus = 0, per_cu = 0;
        if (hipGetDevice(&dev) != hipSuccess || hipDeviceGetAttribute(&cus, hipDeviceAttributeMultiprocessorCount, dev) != hipSuccess) { grid = -1; return; }
        if (hipFuncSetAttribute((const void*)mk_fwd, hipFuncAttributeMaxDynamicSharedMemorySize, LDS_BYTES) != hipSuccess) { fprintf(stderr, "kernel_launch: hipFuncSetAttribute failed\n"); grid = -1; return; }
        if (hipOccupancyMaxActiveBlocksPerMultiprocessor(&per_cu, (const void*)mk_fwd, NWAVES * 64, LDS_BYTES) != hipSuccess || per_cu < 1) fprintf(stderr, "kernel_launch: note: occupancy query reports %d\n", per_cu);
        (void)hipGetLastError();
        grid = cus;
    }
    if (grid < 0) return;
    (void)hipMemsetAsync((char*)d_ws + WS_CTL, 0, CTL_ZERO_BYTES, stream);
    Args a{};
    for (int i = 0; i < 24; ++i) a.in[i] = (const float*)d_in[i];
    a.page_table = (const int*)d_in[5]; a.out = (float*)d_out; a.ws = (unsigned char*)d_ws;
    a.ph_lo = 0; a.ph_hi = N_PHASES; a.p2mask = 15;
    hipLaunchKernelGGL(mk_fwd, dim3(grid), dim3(NWAVES * 64), LDS_BYTES, stream, a);
#if defined(PROBE_TWICE)
    (void)hipMemsetAsync((char*)d_ws + WS_CTL, 0, CTL_ZERO_BYTES, stream);
    hipLaunchKernelGGL(mk_fwd, dim3(grid), dim3(NWAVES * 64), LDS_BYTES, stream, a);
#endif
#if defined(PROBE_RELAUNCH)
    (void)hipMemsetAsync((char*)d_ws + WS_CTL + 64 * 4, 0, (4096 - 64) * 4, stream);
    a.ph_lo = PROBE_RELAUNCH; a.ph_hi = PROBE_RELAUNCH + 1;
#if defined(PROBE_P2MASK)
    a.p2mask = PROBE_P2MASK;
#endif
    hipLaunchKernelGGL(mk_fwd, dim3(grid), dim3(NWAVES * 64), LDS_BYTES, stream, a);
#endif
}
```

```cpp
#include <hip/hip_runtime.h>
#include <cstdio>
#include <cstdint>
#define PROBE_PHASE -1
namespace pg8 {
#define PG8_LAS __attribute__((address_space(3)))
typedef unsigned short bf16_t;
typedef short bf16x8 __attribute__((ext_vector_type(8)));
typedef float f32x4 __attribute__((ext_vector_type(4)));
typedef unsigned u32x4 __attribute__((ext_vector_type(4)));
constexpr int BM = 256, BK = 64, HALF = 128, HTB = HALF * BK * 2  , STAGE_BYTES = 8 * HTB, NXCD = 8, WGM = 8;

__host__ __device__ __forceinline__ int lds_byte(int r, int c) { const int st = (r >> 4) * 2 + (c >> 5), rr = r & 15, cc = c & 31, ob = rr * 64 + cc * 2; return st * 1024 + (ob ^ (((ob >> 9) & 1) << 5)); }
__host__ __device__ __forceinline__ void stage_rc(int b, int& R, int& C) { const int st = b / 1024, sb = b % 1024, swz = sb ^ (((sb >> 9) & 1) << 5); R = (st >> 1) * 16 + swz / 64; C = (st & 1) * 32 + (swz % 64) / 2; }
__host__ __device__ __forceinline__ int perm32(int rho) { const int n = rho >> 4, i = rho & 15; return 8 * (i >> 2) + 4 * n + (i & 3); }

struct Unit { int pm, pn; };
struct Gemm { const bf16_t* A; const bf16_t* Bt; int M, N, K; };

struct StaticOrder {
    int nM, nN, nwg, G, c, wgm;
    __host__ __device__ void init(int M, int N, int G_, int c_, int wgm_ = WGM) { nM = M / BM; nN = N / BM; nwg = nM * nN; G = G_; c = c_; wgm = wgm_; }
    __host__ __device__ bool next(int i, Unit& u) const {
        const long L = (long)i * G + c; if (L >= nwg) return false;
        int wgid = (int)L; { const int q = nwg / NXCD, r = nwg % NXCD, xcd = wgid % NXCD, off = wgid / NXCD; wgid = (xcd < r ? xcd * (q + 1) : r * (q + 1) + (xcd - r) * q) + off; }
        const int nig = wgm * nN, gid = wgid / nig, fm = gid * wgm, gsz = (nM - fm) < wgm ? (nM - fm) : wgm;
        u.pm = fm + ((wgid % nig) % gsz); u.pn = (wgid % nig) / gsz; return true;
    }
    __device__ __forceinline__ void a_ready(const Unit&) const {}
    __device__ __forceinline__ void done(const Unit&) const {}
};

__device__ __forceinline__ unsigned cvt_pk_bf16(float lo, float hi) { unsigned r; asm volatile("v_cvt_pk_bf16_f32 %0, %1, %2" : "=v"(r) : "v"(lo), "v"(hi)); return r; }
__device__ __forceinline__ float bf2f(unsigned short h) { return __uint_as_float((unsigned)h << 16); }
__device__ __forceinline__ float sigmoidf_(float x) { return __builtin_amdgcn_rcpf(1.0f + __expf(-x)); }
__device__ __forceinline__ u32x4 pack8(const f32x4 a, const f32x4 b) { u32x4 w; w.x = cvt_pk_bf16(a[0], a[1]); w.y = cvt_pk_bf16(a[2], a[3]); w.z = cvt_pk_bf16(b[0], b[1]); w.w = cvt_pk_bf16(b[2], b[3]); return w; }
__device__ __forceinline__ void unpack8(const u32x4 w, f32x4& a, f32x4& b) {
    a[0] = __uint_as_float(w.x << 16); a[1] = __uint_as_float(w.x & 0xffff0000u); a[2] = __uint_as_float(w.y << 16); a[3] = __uint_as_float(w.y & 0xffff0000u);
    b[0] = __uint_as_float(w.z << 16); b[1] = __uint_as_float(w.z & 0xffff0000u); b[2] = __uint_as_float(w.w << 16); b[3] = __uint_as_float(w.w & 0xffff0000u); }

struct EpiInProj {
    static constexpr bool PERM = true, AFTER_DRAIN = false, HAS_MID = false;
    bf16_t* U; float* G; float* out_kp; float* out_vp; float* out_ks; float* out_vs; const float* lbl; int n_in, mp, mreal; float qscale;
    __device__ __forceinline__ void operator()(const f32x4 (&acc)[2][2][4][2], const Unit& u, int wr, int wc, int fr, int fq) const {
        const int pn = u.pn, row0 = u.pm * BM + wr * 64 + fr, colb = pn * BM + wc * 32 + 8 * fq;
        const int grp = pn >> 2;
        if (grp == 1) {
            float lb[2][8];
#pragma unroll
            for (int bj = 0; bj < 2; ++bj)
#pragma unroll
                for (int e = 0; e < 8; ++e) { const int c = colb + bj * HALF + e - 1024; const float l0 = lbl[c], l1 = lbl[1024 + c]; lb[bj][e] = 1.0f / (1.0f + expf(l1 - l0)); }
#pragma unroll
            for (int ai = 0; ai < 2; ++ai)
#pragma unroll
                for (int m = 0; m < 4; ++m) { const size_t row = (size_t)(row0 + ai * HALF + m * 16);
#pragma unroll
                    for (int bj = 0; bj < 2; ++bj) { f32x4 v0 = acc[ai][bj][m][0], v1 = acc[ai][bj][m][1], k0, k1;
#pragma unroll
                        for (int e = 0; e < 4; ++e) { const float s0 = __builtin_amdgcn_rcpf(1.0f + __expf(-v0[e])), s1 = __builtin_amdgcn_rcpf(1.0f + __expf(-v1[e])), a0 = 1.0f - lb[bj][e], a1 = 1.0f - lb[bj][4 + e];
                            v0[e] = __logf(lb[bj][e] + a0 * s0); v1[e] = __logf(lb[bj][4 + e] + a1 * s1); k0[e] = a0 * (1.0f - s0); k1[e] = a1 * (1.0f - s1); }
                        float* gp = G + row * 1024 + (colb + bj * HALF - 1024); *(f32x4*)gp = v0; *(f32x4*)(gp + 4) = v1;
                        *(u32x4*)(U + row * n_in + colb + bj * HALF) = pack8(k0, k1); } }
            return;
        }
#pragma unroll
        for (int ai = 0; ai < 2; ++ai)
#pragma unroll
            for (int m = 0; m < 4; ++m) { const int row = row0 + ai * HALF + m * 16;
#pragma unroll
                for (int bj = 0; bj < 2; ++bj) { f32x4 v0 = acc[ai][bj][m][0], v1 = acc[ai][bj][m][1]; const int col = colb + bj * HALF;
                    if (grp == 5 || grp == 6) {
                        float* o = nullptr;
                        if (row < mp) o = (grp == 5 ? out_kp : out_vp) + (size_t)row * 1024; else if (row < mreal) o = (grp == 5 ? out_ks : out_vs) + (size_t)(row - mp) * 1024;
                        if (o) { o += col - (grp == 5 ? 5120 : 6144); *(f32x4*)o = v0; *(f32x4*)(o + 4) = v1; }
                    } else if (grp == 3) {
#pragma unroll
                        for (int e = 0; e < 4; ++e) { v0[e] = v0[e] * sigmoidf_(v0[e]); v1[e] = v1[e] * sigmoidf_(v1[e]); }
                    } else if (grp == 4) { v0 = v0 * qscale; v1 = v1 * qscale; }
                    else if (grp >= 7) {
#pragma unroll
                        for (int e = 0; e < 4; ++e) { v0[e] = sigmoidf_(v0[e]); v1[e] = sigmoidf_(v1[e]); }
                    }
                    *(u32x4*)(U + (size_t)row * n_in + col) = pack8(v0, v1); } }
    }
};
struct EpiBf16Plain {
    static constexpr bool PERM = true, AFTER_DRAIN = false, HAS_MID = false;
    bf16_t* Y; int ldc;
    __device__ __forceinline__ void operator()(const f32x4 (&acc)[2][2][4][2], const Unit& u, int wr, int wc, int fr, int fq) const {
        const int row0 = u.pm * BM + wr * 64 + fr, colb = u.pn * BM + wc * 32 + 8 * fq;
#pragma unroll
        for (int ai = 0; ai < 2; ++ai)
#pragma unroll
            for (int m = 0; m < 4; ++m) { const size_t row = (size_t)(row0 + ai * HALF + m * 16);
#pragma unroll
                for (int bj = 0; bj < 2; ++bj) *(u32x4*)(Y + row * ldc + colb + bj * HALF) = pack8(acc[ai][bj][m][0], acc[ai][bj][m][1]); }
    }
};
struct EpiSwiGLU {
    static constexpr bool PERM = true, AFTER_DRAIN = false, HAS_MID = false;
    bf16_t* HID; int ldh;
    __device__ __forceinline__ void operator()(const f32x4 (&acc)[2][2][4][2], const Unit& u, int wr, int wc, int fr, int fq) const {
        const int row0 = u.pm * BM + wr * 64 + fr, col = u.pn * HALF + wc * 32 + 8 * fq;
#pragma unroll
        for (int ai = 0; ai < 2; ++ai)
#pragma unroll
            for (int m = 0; m < 4; ++m) { const size_t row = (size_t)(row0 + ai * HALF + m * 16);
                f32x4 a = acc[ai][0][m][0], b = acc[ai][0][m][1]; const f32x4 ua = acc[ai][1][m][0], ub = acc[ai][1][m][1];
#pragma unroll
                for (int e = 0; e < 4; ++e) { a[e] = a[e] * sigmoidf_(a[e]) * ua[e]; b[e] = b[e] * sigmoidf_(b[e]) * ub[e]; }
                *(u32x4*)(HID + row * ldh + col) = pack8(a, b); }
    }
};

struct EpiBranchCat {
    static constexpr bool PERM = true, AFTER_DRAIN = false, HAS_MID = true;
    const bf16_t* SGH; const bf16_t* SGD; int ldsg; bf16_t* MIX;
    __device__ __forceinline__ void mid(f32x4 (&acc)[2][2][4][2], const Unit& u, int wr, int wc, int fr, int fq) const {
        int opq = 0; asm volatile("" : "+v"(opq));
        const int row0 = u.pm * BM + wr * 64 + fr + opq, colb = u.pn * BM + wc * 32 + 8 * fq;
#define SC2_(A, lo, hw, dw) A[lo] *= __uint_as_float((hw) << 16) * __builtin_amdgcn_rcpf(fmaxf(__uint_as_float((dw) << 16), 1e-20f)); A[lo + 1] *= __uint_as_float((hw) & 0xffff0000u) * __builtin_amdgcn_rcpf(fmaxf(__uint_as_float((dw) & 0xffff0000u), 1e-20f))
#pragma unroll
        for (int ai = 0; ai < 2; ++ai) {
            u32x4 hw[4][2], dw[4][2];
#pragma unroll
            for (int m = 0; m < 4; ++m) { const size_t row = (size_t)(row0 + ai * HALF + m * 16);
#pragma unroll
                for (int bj = 0; bj < 2; ++bj) { const int col = colb + bj * HALF; hw[m][bj] = *(const u32x4*)(SGH + row * ldsg + col); dw[m][bj] = *(const u32x4*)(SGD + row * ldsg + col); } }
#pragma unroll
            for (int m = 0; m < 4; ++m)
#pragma unroll
                for (int bj = 0; bj < 2; ++bj) { SC2_(acc[ai][bj][m][0], 0, hw[m][bj].x, dw[m][bj].x); SC2_(acc[ai][bj][m][0], 2, hw[m][bj].y, dw[m][bj].y); SC2_(acc[ai][bj][m][1], 0, hw[m][bj].z, dw[m][bj].z); SC2_(acc[ai][bj][m][1], 2, hw[m][bj].w, dw[m][bj].w); }
            asm volatile("" ::: "memory"); }
#undef SC2_
    }
    __device__ __forceinline__ void operator()(const f32x4 (&acc)[2][2][4][2], const Unit& u, int wr, int wc, int fr, int fq) const {
        const int row0 = u.pm * BM + wr * 64 + fr, colb = u.pn * BM + wc * 32 + 8 * fq;
#pragma unroll
        for (int ai = 0; ai < 2; ++ai)
#pragma unroll
            for (int m = 0; m < 4; ++m) { const size_t row = (size_t)(row0 + ai * HALF + m * 16);
#pragma unroll
                for (int bj = 0; bj < 2; ++bj) { const int col = colb + bj * HALF; f32x4 d0, d1; unpack8(*(const u32x4*)(SGD + row * ldsg + col), d0, d1);
#pragma unroll
                    for (int e = 0; e < 4; ++e) { d0[e] = fmaxf(d0[e], 1e-20f); d1[e] = fmaxf(d1[e], 1e-20f); }
                    *(u32x4*)(MIX + row * 2048 + col) = pack8(acc[ai][bj][m][0] * d0, acc[ai][bj][m][1] * d1); } }
    }
};
template <class Epi, class Sched, bool ALIGN_EPI = false, bool SP2 = false>
__device__ __forceinline__ void gemm_phase(PG8_LAS unsigned char* lds, const Gemm g, const Sched& S, const Epi& E) {
    const int tid = threadIdx.x, wid = __builtin_amdgcn_readfirstlane(tid >> 6), lane = tid & 63, wr = wid >> 2, wc = wid & 3, fr = lane & 15, fq = lane >> 4;
    const int K = g.K, nt = K / BK;
    unsigned voffA[2], voffB[2];
#pragma unroll
    for (int i = 0; i < 2; ++i) { int R, C; stage_rc(tid * 16 + i * 8192, R, C); const int Rb = Epi::PERM ? ((R & ~31) + perm32(R & 31)) : R;
        voffA[i] = (unsigned)(R * K + C) * 2u; voffB[i] = (unsigned)(Rb * K + C) * 2u; }
    const size_t kstep = (size_t)(BK * 2);
    const size_t hstep = (size_t)HALF * K * 2;
    const size_t tstep = 2 * hstep;
    const unsigned ldsw = (unsigned)wid * 1024u;
    const int aoff = lds_byte(wr * 64 + fr, fq * 8), boff = lds_byte(wc * 32 + fr, fq * 8);
#define PG8_SA(b, h) (((b) * 2 + (h)) * HTB)
#define PG8_SB(b, h) ((4 + (b) * 2 + (h)) * HTB)
#define PG8_STAGE(bufoff, gbase, voff) do { _Pragma("unroll") for (int _i = 0; _i < 2; ++_i) \
        __builtin_amdgcn_global_load_lds((const unsigned*)((const char*)(gbase) + (voff)[_i]), (PG8_LAS unsigned*)(lds + (bufoff) + ldsw + _i * 8192), 16, 0, 0); } while (0)
#define PG8_LDA(dst, b, h) do { _Pragma("unroll") for (int m = 0; m < 4; ++m) _Pragma("unroll") for (int k = 0; k < 2; ++k) dst[m][k] = *(const PG8_LAS bf16x8*)(lds + PG8_SA(b, h) + aoff + m * 2048 + k * 1024); } while (0)
#define PG8_LDB(dst, b, h) do { _Pragma("unroll") for (int n = 0; n < 2; ++n) _Pragma("unroll") for (int k = 0; k < 2; ++k) dst[n][k] = *(const PG8_LAS bf16x8*)(lds + PG8_SB(b, h) + boff + n * 2048 + k * 1024); } while (0)
#define PG8_MMA(ai, bj, At, Bt) do { __builtin_amdgcn_s_setprio(1); _Pragma("unroll") for (int m = 0; m < 4; ++m) _Pragma("unroll") for (int n = 0; n < 2; ++n) _Pragma("unroll") for (int k = 0; k < 2; ++k) \
        acc[ai][bj][m][n] = __builtin_amdgcn_mfma_f32_16x16x32_bf16(Bt[n][k], At[m][k], acc[ai][bj][m][n], 0, 0, 0); __builtin_amdgcn_s_setprio(0); } while (0)
#define PG8_WAIT_V(n) asm volatile("s_waitcnt vmcnt(" #n ")" ::: "memory")
#define PG8_WAIT_L(n) asm volatile("s_waitcnt lgkmcnt(" #n ")" ::: "memory")
#define PG8_BAR __builtin_amdgcn_s_barrier()
#define PG8_SCHED __builtin_amdgcn_sched_barrier(0)
    Unit cur, nxt; int ui = 0;
    if (!S.next(0, cur)) return;
    f32x4 acc[2][2][4][2];
#pragma unroll
    for (int a = 0; a < 2; ++a)
#pragma unroll
        for (int b = 0; b < 2; ++b)
#pragma unroll
            for (int m = 0; m < 4; ++m)
#pragma unroll
                for (int n = 0; n < 2; ++n) acc[a][b][m][n] = (f32x4){0.f, 0.f, 0.f, 0.f};
    bf16x8 At[4][2], B0[2][2], B1[2][2];
    const char* cA = (const char*)g.A + (size_t)cur.pm * tstep; const char* cB = (const char*)g.Bt + (size_t)cur.pn * tstep;
    S.a_ready(cur);
    if constexpr (SP2) {
        PG8_STAGE(PG8_SB(0, 0), cB, voffB); PG8_STAGE(PG8_SB(0, 1), cB + hstep, voffB); PG8_STAGE(PG8_SA(0, 0), cA, voffA); PG8_STAGE(PG8_SA(0, 1), cA + hstep, voffA);
        if (wr == 1) PG8_BAR;
        PG8_WAIT_V(2); PG8_BAR;
        PG8_STAGE(PG8_SB(1, 0), cB + kstep, voffB); PG8_STAGE(PG8_SA(1, 0), cA + kstep, voffA); PG8_STAGE(PG8_SB(1, 1), cB + hstep + kstep, voffB);
        PG8_WAIT_V(6); PG8_BAR;
    } else {
        PG8_STAGE(PG8_SB(0, 0), cB, voffB); PG8_STAGE(PG8_SA(0, 0), cA, voffA); PG8_STAGE(PG8_SB(0, 1), cB + hstep, voffB); PG8_STAGE(PG8_SA(0, 1), cA + hstep, voffA);
        if (wr == 1) PG8_BAR;
        PG8_WAIT_V(4); PG8_BAR;
        PG8_STAGE(PG8_SB(1, 0), cB + kstep, voffB); PG8_STAGE(PG8_SA(1, 0), cA + kstep, voffA); PG8_STAGE(PG8_SB(1, 1), cB + hstep + kstep, voffB);
        PG8_WAIT_V(6); PG8_BAR;
    }
    for (;;) {
        const bool has_next = S.next(ui + 1, nxt);
        const char* nA = has_next ? (const char*)g.A + (size_t)nxt.pm * tstep : cA; const char* nB = has_next ? (const char*)g.Bt + (size_t)nxt.pn * tstep : cB;
        for (int t = 0; t < nt; t += 2) {
            const bool last = (t == nt - 2);
            const char* a1 = cA + (size_t)(t + 1) * kstep;
            const char* a2 = last ? nA : cA + (size_t)(t + 2) * kstep; const char* b2 = last ? nB : cB + (size_t)(t + 2) * kstep;
            const char* a3 = a2 + kstep; const char* b3 = b2 + kstep;
            if (last && has_next) S.a_ready(nxt);
            if constexpr (Epi::HAS_MID) { if (t == (nt >> 1)) E.mid(acc, cur, wr, wc, fr, fq); }
            if constexpr (SP2) {
            PG8_LDB(B0, 0, 0); PG8_LDB(B1, 0, 1); PG8_SCHED; PG8_LDA(At, 0, 0); PG8_STAGE(PG8_SA(1, 1), a1 + hstep, voffA);
            PG8_WAIT_V(8); PG8_WAIT_L(0); PG8_BAR; PG8_MMA(0, 0, At, B0); PG8_MMA(0, 1, At, B1); PG8_BAR; PG8_SCHED;
            PG8_LDA(At, 0, 1); PG8_STAGE(PG8_SB(0, 0), b2, voffB); PG8_STAGE(PG8_SB(0, 1), b2 + hstep, voffB); PG8_STAGE(PG8_SA(0, 0), a2, voffA);
            PG8_WAIT_V(8); PG8_WAIT_L(0); PG8_BAR; PG8_MMA(1, 0, At, B0); PG8_MMA(1, 1, At, B1); PG8_BAR; PG8_SCHED;
            PG8_LDB(B0, 1, 0); PG8_LDB(B1, 1, 1); PG8_SCHED; PG8_LDA(At, 1, 0); PG8_STAGE(PG8_SA(0, 1), a2 + hstep, voffA);
            PG8_WAIT_V(8); PG8_WAIT_L(0); PG8_BAR; PG8_MMA(0, 0, At, B0); PG8_MMA(0, 1, At, B1); PG8_BAR; PG8_SCHED;
            PG8_LDA(At, 1, 1); PG8_STAGE(PG8_SB(1, 0), b3, voffB); PG8_STAGE(PG8_SB(1, 1), b3 + hstep, voffB); PG8_STAGE(PG8_SA(1, 0), a3, voffA);
            PG8_WAIT_V(8); PG8_WAIT_L(0); PG8_BAR; PG8_MMA(1, 0, At, B0); PG8_MMA(1, 1, At, B1); PG8_BAR; PG8_SCHED;
            } else {
            PG8_LDB(B0, 0, 0); PG8_SCHED; PG8_LDA(At, 0, 0); PG8_STAGE(PG8_SA(1, 1), a1 + hstep, voffA);
            PG8_WAIT_L(8); PG8_BAR; PG8_WAIT_L(0); PG8_MMA(0, 0, At, B0); PG8_BAR; PG8_SCHED;
            PG8_LDB(B1, 0, 1); PG8_STAGE(PG8_SB(0, 0), b2, voffB);
            PG8_BAR; PG8_WAIT_L(0); PG8_MMA(0, 1, At, B1); PG8_BAR;
            PG8_LDA(At, 0, 1); PG8_STAGE(PG8_SA(0, 0), a2, voffA);
            PG8_BAR; PG8_WAIT_L(0); PG8_MMA(1, 0, At, B0); PG8_BAR; PG8_SCHED;
            PG8_STAGE(PG8_SB(0, 1), b2 + hstep, voffB);
            PG8_WAIT_V(6); PG8_BAR; PG8_MMA(1, 1, At, B1); PG8_BAR;
            PG8_LDB(B0, 1, 0); PG8_SCHED; PG8_LDA(At, 1, 0); PG8_STAGE(PG8_SA(0, 1), a2 + hstep, voffA);
            PG8_WAIT_L(8); PG8_BAR; PG8_WAIT_L(0); PG8_MMA(0, 0, At, B0); PG8_BAR; PG8_SCHED;
            PG8_LDB(B1, 1, 1); PG8_STAGE(PG8_SB(1, 0), b3, voffB);
            PG8_BAR; PG8_WAIT_L(0); PG8_MMA(0, 1, At, B1); PG8_BAR;
            PG8_LDA(At, 1, 1); PG8_STAGE(PG8_SA(1, 0), a3, voffA);
            PG8_BAR; PG8_WAIT_L(0); PG8_MMA(1, 0, At, B0); PG8_BAR; PG8_SCHED;
            PG8_STAGE(PG8_SB(1, 1), b3 + hstep, voffB);
            PG8_WAIT_V(6); PG8_BAR; PG8_MMA(1, 1, At, B1); PG8_BAR;
            }
        }
        if constexpr (ALIGN_EPI) { if (wr == 0) PG8_BAR; }
        if constexpr (!Epi::AFTER_DRAIN) { E(acc, cur, wr, wc, fr, fq); S.done(cur); }
        if (!has_next) break;
#pragma unroll
        for (int a = 0; a < 2; ++a)
#pragma unroll
            for (int b = 0; b < 2; ++b)
#pragma unroll
                for (int m = 0; m < 4; ++m)
#pragma unroll
                    for (int n = 0; n < 2; ++n) acc[a][b][m][n] = (f32x4){0.f, 0.f, 0.f, 0.f};
        cur = nxt; cA = nA; cB = nB; ++ui;
        if constexpr (ALIGN_EPI) { if (wr == 1) PG8_BAR; }
    }
    PG8_WAIT_V(0);
    if constexpr (!ALIGN_EPI) { if (wr == 0) PG8_BAR; }
    PG8_BAR;
    if constexpr (Epi::AFTER_DRAIN) { E.fused(acc, cur, wr, wc, fr, fq, lds, wid, lane); S.done(cur); }
#undef PG8_SA
#undef PG8_SB
#undef PG8_STAGE
#undef PG8_LDA
#undef PG8_LDB
#undef PG8_MMA
#undef PG8_WAIT_V
#undef PG8_WAIT_L
#undef PG8_BAR
#undef PG8_SCHED
}
}
#define GAS __attribute__((address_space(1)))
#define LAS __attribute__((address_space(3)))
typedef unsigned short bf16;
typedef unsigned v4u __attribute__((ext_vector_type(4)));
typedef float f32x4 __attribute__((ext_vector_type(4)));
typedef short bf16x8 __attribute__((ext_vector_type(8)));
typedef GAS unsigned gu32;
typedef GAS unsigned long long gu64;
#define RLX_AGENT __ATOMIC_RELAXED, __HIP_MEMORY_SCOPE_AGENT
#define LDS_WAIT() asm volatile("s_waitcnt lgkmcnt(0)" ::: "memory")
#define VM_WAIT() asm volatile("s_waitcnt vmcnt(0)" ::: "memory")
__device__ __forceinline__ unsigned long long rt() { return __builtin_amdgcn_s_memrealtime(); }
__device__ __forceinline__ unsigned f2bf(float f) { unsigned u = __builtin_bit_cast(unsigned, f); return (u + 0x7fffu + ((u >> 16) & 1u)) >> 16; }
__device__ __forceinline__ unsigned pk2(float lo, float hi) { return f2bf(lo) | (f2bf(hi) << 16); }
#define XB_TMO      128
#define XB_XCNT(j)  (256  + 64 * (j))
#define XB_XSUB(j)  (1280 + 64 * (j))
#define XB_XGEN(j)  (2304 + 64 * (j))
#define XB_TOP      3328
#define XB_TOPGEN   3392
#define XCD_BAR_WORDS 3456
#define XB_SPIN_CAP (1u << 18)

__device__ __forceinline__ unsigned xb_ld(unsigned* p)              { return __hip_atomic_load(p, __ATOMIC_RELAXED, __HIP_MEMORY_SCOPE_AGENT); }
__device__ __forceinline__ unsigned xb_add(unsigned* p, unsigned v) { return __hip_atomic_fetch_add(p, v, __ATOMIC_RELAXED, __HIP_MEMORY_SCOPE_AGENT); }
__device__ __forceinline__ unsigned xb_xcc_id() { return (unsigned)__builtin_amdgcn_s_getreg((3 << 11) | 20) & 0xFu; }
#define XB_SPIN(cond, bar) do { unsigned _sp = 0; while (cond) { __builtin_amdgcn_s_sleep(1); \
    if ((++_sp & 255u) == 0u) { if (xb_ld(&(bar)[XB_TMO])) break; if (_sp > XB_SPIN_CAP) { atomicAdd(&(bar)[XB_TMO], 1u); break; } } } } while (0)

struct XcdBarrier {
    unsigned* bar; unsigned x;
    volatile LAS unsigned* st;
};

__device__ __forceinline__ XcdBarrier xcd_barrier_post(unsigned* bar, volatile LAS unsigned* st) {
    XcdBarrier b; b.bar = bar; b.x = xb_xcc_id(); b.st = st;
    if (threadIdx.x == 0) (void)xb_add(&bar[XB_XCNT(b.x)], 1u);
    return b;
}
__device__ __forceinline__ void xcd_barrier_complete(unsigned* bar, unsigned x, unsigned& nloc, unsigned& nx) {
    const unsigned G = gridDim.x * gridDim.y * gridDim.z;
    unsigned sum, cnt, mine, sp = 0u;
    for (;;) {
        sum = 0u; cnt = 0u; mine = 0u;
#pragma unroll
        for (unsigned j = 0; j < 16; ++j) { const unsigned c = xb_ld(&bar[XB_XCNT(j)]); sum += c; cnt += (c > 0u) ? 1u : 0u; mine = (j == x) ? c : mine; }
        if (sum == G) break;
        __builtin_amdgcn_s_sleep(1);
        if ((++sp & 255u) == 0u) { if (xb_ld(&bar[XB_TMO])) break; if (sp > XB_SPIN_CAP) { atomicAdd(&bar[XB_TMO], 1u); break; } }
    }
    nloc = mine > 0u ? mine : 1u; nx = cnt > 0u ? cnt : 1u;
}

__device__ __forceinline__ void xcd_barrier(const XcdBarrier& b) {
    asm volatile("s_waitcnt vmcnt(0)" ::: "memory");
    __syncthreads();
    if (threadIdx.x == 0) {
        unsigned* bar = b.bar;
        __builtin_amdgcn_s_waitcnt(0);
        unsigned nloc = b.st[0], nx = b.st[1];
        if (nloc == 0u) { xcd_barrier_complete(bar, b.x, nloc, nx); b.st[0] = nloc; b.st[1] = nx; }
        const unsigned old = xb_add(&bar[XB_XSUB(b.x)], 1u);
        const unsigned gen = old / nloc;
        if (old + 1u == (gen + 1u) * nloc) {
            __builtin_amdgcn_fence(__ATOMIC_RELEASE, "agent");
            asm volatile("s_waitcnt vmcnt(0)" ::: "memory");
            const unsigned og = xb_add(&bar[XB_TOP], 1u);
            const unsigned tg = og / nx;
            if (og + 1u == (tg + 1u) * nx) xb_add(&bar[XB_TOPGEN], 1u);
            else XB_SPIN(xb_ld(&bar[XB_TOPGEN]) == tg, bar);
            __builtin_amdgcn_fence(__ATOMIC_ACQUIRE, "agent");
            xb_add(&bar[XB_XGEN(b.x)], 1u);
            asm volatile("s_waitcnt vmcnt(0)" ::: "memory");
        } else {
            XB_SPIN(xb_ld(&bar[XB_XGEN(b.x)]) == gen, bar);
            __builtin_amdgcn_fence(__ATOMIC_ACQUIRE, "agent");
            asm volatile("s_waitcnt vmcnt(0)" ::: "memory");
        }
    }
    __syncthreads();
}
constexpr int NWAVES = 8;
constexpr int DM = 2048, PB = 4, PL = 2048, MP = PB * PL, SB = 8, SL = 8, MS = SB * SL, MREAL = MP + MS, MT = 8448;
constexpr int NIN = 11264, DFF = 5632, NH = 8, HDK = 128, HDV = 128, DAH = 8, DADH = 64, DADV = 128;
constexpr int PAST = 16384, PAGE = 128, NPAGES = PAST / PAGE, NPOOL = 1280;
constexpr int C_HQ = 0, C_HF = 1024, C_HI = 2048, C_HGATE = 3072, C_DQ = 4096, C_DK = 5120, C_DV = 6144, C_GHG = 7168, C_GDA = 9216;
constexpr int OPITCH = 2048;
constexpr float RMS_EPS = 1e-6f, LOG2E = 1.4426950408889634f;
constexpr float QSCALE = 0.125f * LOG2E;
constexpr float LAM_INIT = 0.2f;
constexpr size_t O_YP = 0, O_YS = O_YP + (size_t)MP * DM, O_KP = O_YS + (size_t)MS * DM, O_VP = O_KP + (size_t)MP * 1024, O_SP = O_VP + (size_t)MP * 1024,
                 O_KS = O_SP + (size_t)PB * NH * HDK * HDV, O_VS = O_KS + (size_t)MS * 1024, O_SS = O_VS + (size_t)MS * 1024, O_END = O_SS + (size_t)SB * NH * HDK * HDV;
constexpr size_t MiB = 1u << 20;
constexpr size_t WS_CTL = 0, CTL_ZERO_BYTES = 1 * MiB;
constexpr size_t WS_WIN = 2 * MiB, WS_WBH = 48 * MiB, WS_WBD = 48 * MiB + 2048, WS_WOUT = 60 * MiB, WS_WUP = 70 * MiB, WS_WDN = 116 * MiB;
constexpr size_t WS_XN = 140 * MiB, WS_U = 176 * MiB, WS_G = 360 * MiB, WS_OHG = 396 * MiB, WS_ODA = 396 * MiB + 2048, WS_T1 = 432 * MiB, WS_MIX = 500 * MiB,
                 WS_Y1 = 536 * MiB, WS_X1 = 604 * MiB, WS_XN2 = 672 * MiB, WS_HID = 708 * MiB, WS_Y2 = 800 * MiB, WS_DEC = 868 * MiB, WS_X = 904 * MiB, WS_END = 906 * MiB;
static_assert(WS_WIN + (size_t)NIN * DM * 2 <= WS_WBH && WS_WUP + (size_t)NIN * DM * 2 <= WS_WDN && WS_WDN + (size_t)DM * DFF * 2 <= WS_XN && WS_XN + (size_t)MT * DM * 2 <= WS_U &&
              WS_U + (size_t)MT * NIN * 2 <= WS_G && WS_G + (size_t)MT * 1024 * 4 <= WS_OHG && WS_OHG + (size_t)MT * 2048 * 2 <= WS_T1 && WS_WBH + (size_t)DM * 2048 * 2 <= WS_WOUT &&
              WS_T1 + (size_t)MT * DM * 4 <= WS_MIX && WS_MIX + (size_t)MT * DM * 2 <= WS_Y1 && WS_Y1 + (size_t)MT * DM * 4 <= WS_X1 && WS_X1 + (size_t)MT * DM * 4 <= WS_XN2 &&
              WS_XN2 + (size_t)MT * DM * 2 <= WS_HID && WS_HID + (size_t)MT * DFF * 2 <= WS_Y2 && WS_Y2 + (size_t)MT * DM * 4 <= WS_DEC, "d_ws map");
constexpr int CW_TMO = 0, CW_CODE = 1, CW_Q = 64, CW_DCNT = 1024, CW_BAR = 4096, CW_SEAM = 40000, CW_THIN = 60000;
constexpr int RING_OFF = 0, RING_BYTES = 131072;
constexpr int LDSCTL_OFF = RING_BYTES, MISC_OFF = LDSCTL_OFF + 320;
constexpr int LDS_BYTES = 147456;
static_assert(MISC_OFF + 128 <= LDS_BYTES, "LDS map");
struct Args { const float* in[24]; const int* page_table; float* out; unsigned char* ws; int ph_lo, ph_hi, p2mask, pad; };
struct Frame {
    LAS unsigned char* lds; volatile LAS unsigned* MISC; gu32* ctl;
    int tid, lane, wave, vcu, G;
};
__device__ __forceinline__ float wave_sum(float v) {
#pragma unroll
    for (int o = 1; o < 64; o <<= 1) v += __shfl_xor(v, o);
    return v;
}
__device__ __forceinline__ float bf2f(bf16 h) { return __uint_as_float((unsigned)h << 16); }
__device__ __forceinline__ int t5_bucket(int n) {
    if (n < 16) return n;
    if (n >= 113) return 31;
    int b = 16;
    b += (n >= 19); b += (n >= 21); b += (n >= 24); b += (n >= 27); b += (n >= 31); b += (n >= 35); b += (n >= 40); b += (n >= 46);
    b += (n >= 52); b += (n >= 59); b += (n >= 67); b += (n >= 77); b += (n >= 87); b += (n >= 99);
    return b;
}
__device__ __forceinline__ float da_lambda(const Args& a) {
    float s1 = 0.f, s2 = 0.f;
    for (int i = 0; i < DADH; ++i) { s1 += a.in[13][i] * a.in[14][i]; s2 += a.in[15][i] * a.in[16][i]; }
    return expf(s1) - expf(s2) + LAM_INIT;
}
__device__ __forceinline__ void p0_transpose_item(const float* W, int K, int N, bf16* WT, int k0, int n0, int dst_row0, LAS float* scr, int lane, int ldt = 0) {
    if (ldt == 0) ldt = K;
#pragma unroll
    for (int i = 0; i < 8; ++i) { const int kk = 8 * i + (lane >> 3); const f32x4 t = *(const f32x4*)(W + (size_t)(k0 + kk) * N + n0 + 4 * (lane & 7));
        LAS float* d = scr + kk * 33 + 4 * (lane & 7); d[0] = t.x; d[1] = t.y; d[2] = t.z; d[3] = t.w; }
    LDS_WAIT(); asm volatile("" ::: "memory");
    const int c = lane & 7;
#pragma unroll
    for (int j = 0; j < 4; ++j) { const int n = (lane >> 3) + 8 * j; const LAS float* s = scr + (8 * c) * 33 + n;
        v4u o; o.x = pk2(s[0 * 33], s[1 * 33]); o.y = pk2(s[2 * 33], s[3 * 33]); o.z = pk2(s[4 * 33], s[5 * 33]); o.w = pk2(s[6 * 33], s[7 * 33]);
        *(GAS v4u*)(WT + (size_t)(dst_row0 + n) * ldt + k0 + 8 * c) = o; }
    LDS_WAIT(); asm volatile("" ::: "memory");
}
__device__ __forceinline__ void rms_row_to_bf16(const float* xrow, const float* w, bf16* orow, int lane) {
    GAS unsigned long long* o8 = (GAS unsigned long long*)orow + lane;
    if (!xrow) {
#pragma unroll
        for (int j = 0; j < 8; ++j) o8[64 * j] = 0ull;
        return; }
    const GAS f32x4* xr = (const GAS f32x4*)xrow + lane; const GAS f32x4* wr = (const GAS f32x4*)w + lane;
    f32x4 v[8]; float s = 0.f;
#pragma unroll
    for (int j = 0; j < 8; ++j) { v[j] = xr[64 * j]; s += (v[j].x * v[j].x + v[j].y * v[j].y) + (v[j].z * v[j].z + v[j].w * v[j].w); }
    const float rstd = 1.0f / sqrtf(wave_sum(s) * (1.0f / DM) + RMS_EPS);
#pragma unroll
    for (int j = 0; j < 8; ++j) { const f32x4 g = wr[64 * j]; o8[64 * j] = (unsigned long long)pk2(v[j].x * rstd * g.x, v[j].y * rstd * g.y) | ((unsigned long long)pk2(v[j].z * rstd * g.z, v[j].w * rstd * g.w) << 32); }
}
__device__ __forceinline__ void rms_rows2_to_bf16(const float* x0, const float* x1, bool has1, const float* w, bf16* o0, bf16* o1, int lane) {
    const GAS f32x4* wr = (const GAS f32x4*)w + lane;
    f32x4 v0[8], v1[8];
#pragma unroll
    for (int j = 0; j < 8; ++j) { v0[j] = x0 ? ((const GAS f32x4*)x0 + lane)[64 * j] : (f32x4){0.f, 0.f, 0.f, 0.f}; v1[j] = x1 ? ((const GAS f32x4*)x1 + lane)[64 * j] : (f32x4){0.f, 0.f, 0.f, 0.f}; }
    float s0 = 0.f, s1 = 0.f;
#pragma unroll
    for (int j = 0; j < 8; ++j) { s0 += (v0[j].x * v0[j].x + v0[j].y * v0[j].y) + (v0[j].z * v0[j].z + v0[j].w * v0[j].w); s1 += (v1[j].x * v1[j].x + v1[j].y * v1[j].y) + (v1[j].z * v1[j].z + v1[j].w * v1[j].w); }
    const float r0 = 1.0f / sqrtf(wave_sum(s0) * (1.0f / DM) + RMS_EPS), r1 = 1.0f / sqrtf(wave_sum(s1) * (1.0f / DM) + RMS_EPS);
    GAS unsigned long long* p0 = (GAS unsigned long long*)o0 + lane; GAS unsigned long long* p1 = (GAS unsigned long long*)o1 + lane;
#pragma unroll
    for (int j = 0; j < 8; ++j) { const f32x4 g = wr[64 * j];
        p0[64 * j] = (unsigned long long)pk2(v0[j].x * r0 * g.x, v0[j].y * r0 * g.y) | ((unsigned long long)pk2(v0[j].z * r0 * g.z, v0[j].w * r0 * g.w) << 32);
        if (has1) p1[64 * j] = (unsigned long long)pk2(v1[j].x * r1 * g.x, v1[j].y * r1 * g.y) | ((unsigned long long)pk2(v1[j].z * r1 * g.z, v1[j].w * r1 * g.w) << 32); }
}
__device__ __forceinline__ const float* x_row(const Args& a, int m) { return m < MP ? a.in[0] + (size_t)m * DM : (m < MREAL ? a.in[1] + (size_t)(m - MP) * DM : nullptr); }

constexpr int I_IN = (DM / 64) * (NIN / 32), I_BH = (1024 / 64) * (DM / 32), I_OUT = (DM / 64) * (DM / 32), I_UP = I_IN, I_DN = (DFF / 64) * (DM / 32);
constexpr int NITEMS_LATE = 2 * I_BH + I_OUT + I_UP;
struct XItem { const float* src; bf16* dst; int N, ldt; };
__device__ __forceinline__ XItem late_item(const Args& a, int r) {
    unsigned char* ws = a.ws; XItem x;
    if (r < I_BH) { const int nb = DM / 32, kb = r / nb, n0 = 32 * (r % nb); x.src = a.in[19] + (size_t)(64 * kb) * DM + n0; x.dst = (bf16*)(ws + WS_WBH) + (size_t)n0 * OPITCH + 64 * kb; x.N = DM; x.ldt = OPITCH; return x; } r -= I_BH;
    if (r < I_BH) { const int nb = DM / 32, kb = r / nb, n0 = 32 * (r % nb); x.src = a.in[20] + (size_t)(64 * kb) * DM + n0; x.dst = (bf16*)(ws + WS_WBD) + (size_t)n0 * OPITCH + 64 * kb; x.N = DM; x.ldt = OPITCH; return x; } r -= I_BH;
    if (r < I_OUT) { const int nb = DM / 32, kb = r / nb, n0 = 32 * (r % nb); x.src = a.in[21] + (size_t)(64 * kb) * DM + n0; x.dst = (bf16*)(ws + WS_WOUT) + (size_t)n0 * DM + 64 * kb; x.N = DM; x.ldt = DM; return x; } r -= I_OUT;
    { const int nb = NIN / 32, kb = r / nb, n0 = 32 * (r % nb);
      const int isup = n0 >= DFF, nn = isup ? n0 - DFF : n0, dr = 256 * (nn / 128) + (isup ? 128 : 0) + (nn % 128);
      x.src = a.in[22] + (size_t)(64 * kb) * NIN + n0; x.dst = (bf16*)(ws + WS_WUP) + (size_t)dr * DM + 64 * kb; x.N = NIN; x.ldt = DM; return x; }
}
__device__ __forceinline__ XItem dn_item(const Args& a, int r) { const int nb = DM / 32, kb = r / nb, n0 = 32 * (r % nb); XItem x; x.src = a.in[23] + (size_t)(64 * kb) * DM + n0; x.dst = (bf16*)(a.ws + WS_WDN) + (size_t)n0 * DFF + 64 * kb; x.N = DM; x.ldt = DFF; return x; }
__device__ __forceinline__ void x_load(const XItem& x, int lane, f32x4 (&t)[8]) {
#pragma unroll
    for (int i = 0; i < 8; ++i) t[i] = *(const GAS f32x4*)(x.src + (size_t)(8 * i + (lane >> 3)) * x.N + 4 * (lane & 7));
}
__device__ __forceinline__ void x_finish(const XItem& x, const f32x4 (&t)[8], LAS float* scr, int lane) {
#pragma unroll
    for (int i = 0; i < 8; ++i) { LAS float* d = scr + (8 * i + (lane >> 3)) * 33 + 4 * (lane & 7); d[0] = t[i].x; d[1] = t[i].y; d[2] = t[i].z; d[3] = t[i].w; }
    LDS_WAIT(); asm volatile("" ::: "memory");
    const int c = lane & 7;
#pragma unroll
    for (int j = 0; j < 4; ++j) { const int n = (lane >> 3) + 8 * j; const LAS float* s = scr + (8 * c) * 33 + n;
        v4u o; o.x = pk2(s[0 * 33], s[1 * 33]); o.y = pk2(s[2 * 33], s[3 * 33]); o.z = pk2(s[4 * 33], s[5 * 33]); o.w = pk2(s[6 * 33], s[7 * 33]);
        *(GAS v4u*)(x.dst + (size_t)n * x.ldt + 8 * c) = o; }
    LDS_WAIT(); asm volatile("" ::: "memory");
}
template <bool DN>
__device__ __forceinline__ void convert_from_counter(Frame& F, const Args& a, gu32* ctr) {
    constexpr int NIT = DN ? I_DN : NITEMS_LATE; static_assert(NIT % 8 == 0, "batches of 8");
    LAS float* scr = (LAS float*)(F.lds + RING_OFF + F.wave * 16384);
    for (;;) {
        unsigned it = 0; if (F.lane == 0) it = __hip_atomic_fetch_add(ctr, 8u, RLX_AGENT);
        it = (unsigned)__builtin_amdgcn_readfirstlane((int)it);
        if (it >= (unsigned)NIT) break;
        f32x4 ta[8], tb[8];
        XItem xa = DN ? dn_item(a, (int)it) : late_item(a, (int)it), xb;
        x_load(xa, F.lane, ta);
#pragma unroll
        for (int p = 0; p < 4; ++p) {
            xb = DN ? dn_item(a, (int)it + 2 * p + 1) : late_item(a, (int)it + 2 * p + 1); x_load(xb, F.lane, tb);
            x_finish(xa, ta, scr, F.lane);
            if (p < 3) { xa = DN ? dn_item(a, (int)it + 2 * p + 2) : late_item(a, (int)it + 2 * p + 2); x_load(xa, F.lane, ta); }
            x_finish(xb, tb, scr, F.lane);
        }
    }
}
__device__ __forceinline__ void convert_late(Frame& F, const Args& a, gu32* ctr) { convert_from_counter<false>(F, a, ctr); }
__device__ __forceinline__ void convert_dn(Frame& F, const Args& a, gu32* ctr) { convert_from_counter<true>(F, a, ctr); }
__device__ __forceinline__ void p0_prologue(Frame& F, const Args& a) {
    unsigned char* ws = a.ws;
    LAS float* scr = (LAS float*)(F.lds + RING_OFF + F.wave * 16384);
    const int gw = F.vcu * NWAVES + F.wave, NGW = F.G * NWAVES;
    for (int p = gw; p < I_IN / 2; p += NGW) {
        const int nb = NIN / 32; XItem xa, xb; f32x4 ta[8], tb[8];
        { const int it = 2 * p, kb = it / nb, n0 = 32 * (it % nb); xa.src = a.in[10] + (size_t)(64 * kb) * NIN + n0; xa.dst = (bf16*)(ws + WS_WIN) + (size_t)n0 * DM + 64 * kb; xa.N = NIN; xa.ldt = DM; }
        { const int it = 2 * p + 1, kb = it / nb, n0 = 32 * (it % nb); xb.src = a.in[10] + (size_t)(64 * kb) * NIN + n0; xb.dst = (bf16*)(ws + WS_WIN) + (size_t)n0 * DM + 64 * kb; xb.N = NIN; xb.ldt = DM; }
        x_load(xa, F.lane, ta); x_load(xb, F.lane, tb); x_finish(xa, ta, scr, F.lane); x_finish(xb, tb, scr, F.lane); }
    for (int m = gw; m < MT; m += 2 * NGW) rms_rows2_to_bf16(x_row(a, m), m + NGW < MT ? x_row(a, m + NGW) : nullptr, m + NGW < MT, a.in[6], (bf16*)(ws + WS_XN) + (size_t)m * DM, (bf16*)(ws + WS_XN) + (size_t)(m + NGW) * DM, F.lane);
    for (int m = MREAL + gw; m < MT; m += NGW) { rms_row_to_bf16(nullptr, nullptr, (bf16*)(ws + WS_OHG) + (size_t)m * OPITCH, F.lane); rms_row_to_bf16(nullptr, nullptr, (bf16*)(ws + WS_XN2) + (size_t)m * DM, F.lane); }
}
__device__ __forceinline__ f32x4 bf4(unsigned long long w) { const unsigned lo = (unsigned)w, hi = (unsigned)(w >> 32); return (f32x4){__uint_as_float(lo << 16), __uint_as_float(lo & 0xffff0000u), __uint_as_float(hi << 16), __uint_as_float(hi & 0xffff0000u)}; }
template <int NR>
__device__ __forceinline__ void row1(const Args& a, int m0, int stride, int lane) {
    unsigned char* ws = a.ws;
    const GAS f32x4* w1 = (const GAS f32x4*)a.in[7] + lane; const GAS f32x4* w2 = (const GAS f32x4*)a.in[8] + lane;
    unsigned long long yw[NR][8]; f32x4 xv[NR][8];
#pragma unroll
    for (int i = 0; i < NR; ++i) { const int m = m0 + i * stride; if (m < MREAL) {
        const GAS unsigned long long* yr = (const GAS unsigned long long*)((const bf16*)(ws + WS_Y1) + (size_t)m * DM) + lane; const GAS f32x4* xr = (const GAS f32x4*)x_row(a, m) + lane;
#pragma unroll
        for (int j = 0; j < 8; ++j) { yw[i][j] = yr[64 * j]; xv[i][j] = xr[64 * j]; } } }
    f32x4 g1[8];
#pragma unroll
    for (int j = 0; j < 8; ++j) g1[j] = w1[64 * j];
#pragma unroll
    for (int i = 0; i < NR; ++i) { const int m = m0 + i * stride; if (m < MREAL) {
        GAS unsigned long long* o8 = (GAS unsigned long long*)((bf16*)(ws + WS_XN2) + (size_t)m * DM) + lane; GAS unsigned long long* x1o = (GAS unsigned long long*)((bf16*)(ws + WS_X1) + (size_t)m * DM) + lane;
        float s = 0.f;
#pragma unroll
        for (int j = 0; j < 8; ++j) { const f32x4 v = bf4(yw[i][j]); s += (v.x * v.x + v.y * v.y) + (v.z * v.z + v.w * v.w); }
        const float rstd = 1.0f / sqrtf(wave_sum(s) * (1.0f / DM) + RMS_EPS); float s2 = 0.f;
#pragma unroll
        for (int j = 0; j < 8; ++j) { const f32x4 t = xv[i][j] + bf4(yw[i][j]) * rstd * g1[j]; xv[i][j] = t; x1o[64 * j] = (unsigned long long)pk2(t.x, t.y) | ((unsigned long long)pk2(t.z, t.w) << 32); s2 += (t.x * t.x + t.y * t.y) + (t.z * t.z + t.w * t.w); }
        const float rstd2 = 1.0f / sqrtf(wave_sum(s2) * (1.0f / DM) + RMS_EPS);
#pragma unroll
        for (int j = 0; j < 8; ++j) { const f32x4 g = w2[64 * j]; o8[64 * j] = (unsigned long long)pk2(xv[i][j].x * rstd2 * g.x, xv[i][j].y * rstd2 * g.y) | ((unsigned long long)pk2(xv[i][j].z * rstd2 * g.z, xv[i][j].w * rstd2 * g.w) << 32); } } }
}
template <int NR>
__device__ __forceinline__ void row2(const Args& a, int m0, int stride, int lane) {
    unsigned char* ws = a.ws;
    const GAS f32x4* w1 = (const GAS f32x4*)a.in[9] + lane;
    f32x4 v[NR][8]; unsigned long long xw[NR][8];
#pragma unroll
    for (int i = 0; i < NR; ++i) { const int m = m0 + i * stride; if (m < MREAL) {
        const GAS unsigned long long* yr = (const GAS unsigned long long*)((const bf16*)(ws + WS_Y2) + (size_t)m * DM) + lane; const GAS unsigned long long* xr = (const GAS unsigned long long*)((const bf16*)(ws + WS_X1) + (size_t)m * DM) + lane;
#pragma unroll
        for (int j = 0; j < 8; ++j) { v[i][j] = bf4(yr[64 * j]); xw[i][j] = xr[64 * j]; } } }
#pragma unroll
    for (int i = 0; i < NR; ++i) { const int m = m0 + i * stride; if (m < MREAL) {
        GAS f32x4* o = (GAS f32x4*)(m < MP ? a.out + O_YP + (size_t)m * DM : a.out + O_YS + (size_t)(m - MP) * DM) + lane;
        float s = 0.f;
#pragma unroll
        for (int j = 0; j < 8; ++j) s += (v[i][j].x * v[i][j].x + v[i][j].y * v[i][j].y) + (v[i][j].z * v[i][j].z + v[i][j].w * v[i][j].w);
        const float rstd = 1.0f / sqrtf(wave_sum(s) * (1.0f / DM) + RMS_EPS);
#pragma unroll
        for (int j = 0; j < 8; ++j) o[64 * j] = bf4(xw[i][j]) + v[i][j] * rstd * w1[64 * j]; } }
}
__device__ __forceinline__ void row_pass1(Frame& F, const Args& a) { int ln = threadIdx.x; asm volatile("" : "+v"(ln)); ln &= 63;
    const int gw = F.vcu * NWAVES + F.wave, NGW = F.G * NWAVES; for (int m = gw; m < MREAL; m += 3 * NGW) row1<3>(a, m, NGW, ln); }
__device__ __forceinline__ void row_pass2(Frame& F, const Args& a) { int ln = threadIdx.x; asm volatile("" : "+v"(ln)); ln &= 63;
    const int gw = F.vcu * NWAVES + F.wave, NGW = F.G * NWAVES; for (int m = gw; m < MREAL; m += 2 * NGW) row2<2>(a, m, NGW, ln); }
#ifndef PROBE_PHASE
#define PROBE_PHASE -1
#endif
#define HG_PROBE_MUL ((PROBE_PHASE == 23) ? 2 : 1)
namespace hg {
typedef short bf16x8 __attribute__((ext_vector_type(8)));
typedef short s16x4 __attribute__((ext_vector_type(4)));
typedef float f32x4 __attribute__((ext_vector_type(4)));
typedef float f32x2 __attribute__((ext_vector_type(2)));
typedef unsigned u32x2 __attribute__((ext_vector_type(2)));
typedef unsigned u32x4 __attribute__((ext_vector_type(4)));
constexpr int QS_P = 272, KT_P = 144, VS_P = 272, AM_P = 144, OB_P = 528;
constexpr int QS = 0, KS = QS + 64 * QS_P, KT = KS + 64 * QS_P, VS = KT + 128 * KT_P, AM = VS + 64 * VS_P, GS = AM + 64 * AM_P, DEC = GS + 8 * 128 * 4, NWL = DEC + 512, LDS_END = NWL + 512;
constexpr int OB = 0;
static_assert(64 * OB_P <= KT && LDS_END <= 131072, "hgrn LDS map");
__device__ __forceinline__ unsigned pkbf(float lo, float hi) { unsigned r; asm volatile("v_cvt_pk_bf16_f32 %0, %1, %2" : "=v"(r) : "v"(lo), "v"(hi)); return r; }
__device__ __forceinline__ float lo2f(unsigned w) { return __uint_as_float(w << 16); }
__device__ __forceinline__ float hi2f(unsigned w) { return __uint_as_float(w & 0xffff0000u); }
__device__ __forceinline__ s16x4 trd(const LAS unsigned char* p) { typedef short v4i16_t __attribute__((ext_vector_type(4))); return __builtin_bit_cast(s16x4, __builtin_amdgcn_ds_read_tr16_b64_v4i16((LAS v4i16_t*)p)); }
#define HG_BAR() do { asm volatile("s_waitcnt vmcnt(0) lgkmcnt(0)" ::: "memory"); __builtin_amdgcn_s_barrier(); asm volatile("" ::: "memory"); } while (0)
#define HG_LBAR() do { asm volatile("s_waitcnt lgkmcnt(0)" ::: "memory"); __builtin_amdgcn_s_barrier(); asm volatile("" ::: "memory"); } while (0)

__device__ __forceinline__ void prompt_unit(LAS unsigned char* lds, const Args& a, int b, int h) {
    int tid = threadIdx.x; asm volatile("" : "+v"(tid));
    const int lane = tid & 63, w = __builtin_amdgcn_readfirstlane(tid >> 6), q = lane >> 4, li = lane & 15;
    const bf16* U = (const bf16*)(a.ws + WS_U); const float* G = (const float*)(a.ws + WS_G); bf16* OHG = (bf16*)(a.ws + WS_OHG);
    const size_t rbase = (size_t)b * PL;
    if (tid < 128) ((LAS float*)(lds + NWL))[tid] = a.in[12][tid];
    f32x4 S[8];
#pragma unroll
    for (int i = 0; i < 8; ++i) S[i] = (f32x4){0.f, 0.f, 0.f, 0.f};
    f32x2 g2[8]; unsigned qv[8], kv[8]; u32x4 vv[2];
#define HG_PREFETCH(n) do { _Pragma("unroll") for (int r = 0; r < 8; ++r) { const size_t row = rbase + (size_t)(n) * 64 + 8 * w + r; \
            g2[r] = *(const f32x2*)(G + row * 1024 + h * HDK + 2 * lane); qv[r] = *(const unsigned*)(U + row * NIN + C_HQ + h * HDK + 2 * lane); kv[r] = *(const unsigned*)(U + row * NIN + C_HF + h * HDK + 2 * lane); } \
        { const bf16* vp = U + (rbase + (size_t)(n) * 64 + (tid >> 3)) * NIN + C_HI + h * HDV + (tid & 7) * 16; vv[0] = *(const u32x4*)vp; vv[1] = *(const u32x4*)(vp + 8); } } while (0)
    HG_PREFETCH(0);
    for (int nn = 0; nn < (PL / 64) * HG_PROBE_MUL; ++nn) { const int n = nn & (PL / 64 - 1);
        if (HG_PROBE_MUL > 1 && nn == PL / 64) {
#pragma unroll
            for (int i = 0; i < 8; ++i) S[i] = (f32x4){0.f, 0.f, 0.f, 0.f}; }
        float c0[8], c1[8];
        { float s0 = 0.f, s1 = 0.f;
#pragma unroll
          for (int r = 0; r < 8; ++r) { s0 += g2[r].x * LOG2E; s1 += g2[r].y * LOG2E; c0[r] = s0; c1[r] = s1; }
          *(LAS f32x2*)(lds + GS + (w * 128 + 2 * lane) * 4) = (f32x2){s0, s1}; }
        HG_LBAR();
        float off0 = 0.f, off1 = 0.f, tot0 = 0.f, tot1 = 0.f;
#pragma unroll
        for (int j = 0; j < 8; ++j) { const f32x2 t = *(const LAS f32x2*)(lds + GS + (j * 128 + 2 * lane) * 4); tot0 += t.x; tot1 += t.y; if (j < w) { off0 += t.x; off1 += t.y; } }
        const float dl0 = __builtin_amdgcn_exp2f(tot0), dl1 = __builtin_amdgcn_exp2f(tot1);
        if (w == 0) *(LAS f32x2*)(lds + DEC + 2 * lane * 4) = (f32x2){dl0, dl1};
        float kd0[8], kd1[8];
#pragma unroll
        for (int r = 0; r < 8; ++r) { const float G0 = off0 + c0[r], G1 = off1 + c1[r];
            const float e0 = __builtin_amdgcn_exp2f(G0), e1 = __builtin_amdgcn_exp2f(G1), i0 = __builtin_amdgcn_exp2f(-G0), i1 = __builtin_amdgcn_exp2f(-G1);
            const float kg0 = lo2f(kv[r]) * i0, kg1 = hi2f(kv[r]) * i1;
            *(LAS unsigned*)(lds + QS + (8 * w + r) * QS_P + lane * 4) = pkbf(lo2f(qv[r]) * e0, hi2f(qv[r]) * e1);
            *(LAS unsigned*)(lds + KS + (8 * w + r) * QS_P + lane * 4) = pkbf(kg0, kg1);
            kd0[r] = kg0 * dl0; kd1[r] = kg1 * dl1; }
        *(LAS u32x4*)(lds + KT + (2 * lane) * KT_P + w * 16) = (u32x4){pkbf(kd0[0], kd0[1]), pkbf(kd0[2], kd0[3]), pkbf(kd0[4], kd0[5]), pkbf(kd0[6], kd0[7])};
        *(LAS u32x4*)(lds + KT + (2 * lane + 1) * KT_P + w * 16) = (u32x4){pkbf(kd1[0], kd1[1]), pkbf(kd1[2], kd1[3]), pkbf(kd1[4], kd1[5]), pkbf(kd1[6], kd1[7])};
        *(LAS u32x4*)(lds + VS + (tid >> 3) * VS_P + (tid & 7) * 32) = vv[0]; *(LAS u32x4*)(lds + VS + (tid >> 3) * VS_P + (tid & 7) * 32 + 16) = vv[1];
        HG_LBAR();
        if (nn + 1 < (PL / 64) * HG_PROBE_MUL) HG_PREFETCH((n + 1) & (PL / 64 - 1));
        u32x4 gt0, gt1; { const bf16* gp = U + (rbase + (size_t)n * 64 + (tid >> 3)) * NIN + C_HGATE + h * HDV + (tid & 7) * 16; gt0 = *(const u32x4*)gp; gt1 = *(const u32x4*)(gp + 8); }
#pragma unroll
        for (int tt = 0; tt < 2; ++tt) { const int t = 2 * w + tt, ci = t >> 2, si = t & 3;
            f32x4 acc = (f32x4){0.f, 0.f, 0.f, 0.f};
#pragma unroll
            for (int kd = 0; kd < 4; ++kd) { const bf16x8 af = *(const LAS bf16x8*)(lds + KS + (16 * si + li) * QS_P + (32 * kd + 8 * q) * 2), bf = *(const LAS bf16x8*)(lds + QS + (16 * ci + li) * QS_P + (32 * kd + 8 * q) * 2);
                acc = __builtin_amdgcn_mfma_f32_16x16x32_bf16(af, bf, acc, 0, 0, 0); }
            const int cc = 16 * ci + li, sb = 16 * si + 4 * q;
#pragma unroll
            for (int r = 0; r < 4; ++r) if (sb + r > cc) acc[r] = 0.f;
            *(LAS u32x2*)(lds + AM + cc * AM_P + sb * 2) = (u32x2){pkbf(acc[0], acc[1]), pkbf(acc[2], acc[3])}; }
        f32x4 O[4];
#pragma unroll
        for (int m = 0; m < 4; ++m) O[m] = (f32x4){0.f, 0.f, 0.f, 0.f};
#pragma unroll
        for (int ks = 0; ks < 4; ++ks) { const u32x4 sb4 = (u32x4){pkbf(S[2 * ks][0], S[2 * ks][1]), pkbf(S[2 * ks][2], S[2 * ks][3]), pkbf(S[2 * ks + 1][0], S[2 * ks + 1][1]), pkbf(S[2 * ks + 1][2], S[2 * ks + 1][3])};
            const bf16x8 sb = __builtin_bit_cast(bf16x8, sb4);
#pragma unroll
            for (int m = 0; m < 4; ++m) { const u32x2 a0 = *(const LAS u32x2*)(lds + QS + (16 * m + li) * QS_P + (32 * ks + 4 * q) * 2), a1 = *(const LAS u32x2*)(lds + QS + (16 * m + li) * QS_P + (32 * ks + 16 + 4 * q) * 2);
                const bf16x8 af = __builtin_bit_cast(bf16x8, (u32x4){a0.x, a0.y, a1.x, a1.y});
                O[m] = __builtin_amdgcn_mfma_f32_16x16x32_bf16(af, sb, O[m], 0, 0, 0); } }
        bf16x8 Vf[2];
#pragma unroll
        for (int k2 = 0; k2 < 2; ++k2) { const LAS unsigned char* vp = lds + VS + (32 * k2 + 8 * q + (li >> 2)) * VS_P + (16 * w + 4 * (li & 3)) * 2;
            const s16x4 lo = trd(vp), hi = trd(vp + 4 * VS_P); Vf[k2] = (bf16x8){lo[0], lo[1], lo[2], lo[3], hi[0], hi[1], hi[2], hi[3]}; }
#pragma unroll
        for (int dt = 0; dt < 8; ++dt) { const f32x4 dc = *(const LAS f32x4*)(lds + DEC + (16 * dt + 4 * q) * 4); S[dt] = S[dt] * dc;
#pragma unroll
            for (int k2 = 0; k2 < 2; ++k2) { const bf16x8 af = *(const LAS bf16x8*)(lds + KT + (16 * dt + li) * KT_P + (32 * k2 + 8 * q) * 2);
                S[dt] = __builtin_amdgcn_mfma_f32_16x16x32_bf16(af, Vf[k2], S[dt], 0, 0, 0); } }
        HG_LBAR();
#pragma unroll
        for (int m = 0; m < 4; ++m)
#pragma unroll
            for (int k2 = 0; k2 < 2; ++k2) { if (32 * k2 > 16 * m + 15) continue;
                const bf16x8 af = *(const LAS bf16x8*)(lds + AM + (16 * m + li) * AM_P + (32 * k2 + 8 * q) * 2);
                O[m] = __builtin_amdgcn_mfma_f32_16x16x32_bf16(af, Vf[k2], O[m], 0, 0, 0); }
#pragma unroll
        for (int m = 0; m < 4; ++m)
#pragma unroll
            for (int r = 0; r < 4; ++r) *(LAS float*)(lds + OB + (16 * m + 4 * q + r) * OB_P + (16 * w + li) * 4) = O[m][r];
        HG_LBAR();
        { const int c = tid >> 3, sg = tid & 7; f32x4 x[4]; float ss = 0.f;
#pragma unroll
          for (int i = 0; i < 4; ++i) { x[i] = *(const LAS f32x4*)(lds + OB + c * OB_P + sg * 64 + i * 16); ss += (x[i][0] * x[i][0] + x[i][1] * x[i][1]) + (x[i][2] * x[i][2] + x[i][3] * x[i][3]); }
          ss += __shfl_xor(ss, 1); ss += __shfl_xor(ss, 2); ss += __shfl_xor(ss, 4);
          const float rstd = 1.0f / sqrtf(ss * (1.0f / HDV) + RMS_EPS);
          const unsigned gw[8] = {gt0.x, gt0.y, gt0.z, gt0.w, gt1.x, gt1.y, gt1.z, gt1.w}; unsigned ow[8];
#pragma unroll
          for (int i = 0; i < 4; ++i) { const f32x4 nw = *(const LAS f32x4*)(lds + NWL + (sg * 16 + i * 4) * 4);
              ow[2 * i] = pkbf(x[i][0] * rstd * nw[0] * lo2f(gw[2 * i]), x[i][1] * rstd * nw[1] * hi2f(gw[2 * i])); ow[2 * i + 1] = pkbf(x[i][2] * rstd * nw[2] * lo2f(gw[2 * i + 1]), x[i][3] * rstd * nw[3] * hi2f(gw[2 * i + 1])); }
          bf16* op = OHG + (rbase + (size_t)n * 64 + c) * OPITCH + h * HDV + sg * 16;
          *(u32x4*)op = (u32x4){ow[0], ow[1], ow[2], ow[3]}; *(u32x4*)(op + 8) = (u32x4){ow[4], ow[5], ow[6], ow[7]}; }
    }
#undef HG_PREFETCH
    float* So = a.out + O_SP + (size_t)(b * NH + h) * HDK * HDV;
#pragma unroll
    for (int dt = 0; dt < 8; ++dt)
#pragma unroll
        for (int r = 0; r < 4; ++r) So[(size_t)(16 * dt + 4 * q + r) * HDV + 16 * w + li] = S[dt][r];
    HG_BAR();
}

__device__ __forceinline__ void sample_unit(LAS unsigned char* lds, const Args& a, int s, int h) {
    int tid = threadIdx.x; asm volatile("" : "+v"(tid));
    const int v = tid & 127, dg = tid >> 7, lane = tid & 63, wave = tid >> 6;
    LAS float* Fd = (LAS float*)lds; LAS float* Qd = Fd + SL * 128; LAS float* Iv = Qd + SL * 128; LAS float* Gv = Iv + SL * 128; LAS float* red = Gv + SL * 128; LAS float* red2 = red + 512;
    const bf16* U = (const bf16*)(a.ws + WS_U); const float* G = (const float*)(a.ws + WS_G); bf16* OHG = (bf16*)(a.ws + WS_OHG);
    const float* S0 = a.in[4] + (size_t)(s * NH + h) * HDK * HDV; float* Sout = a.out + O_SS + (size_t)(s * NH + h) * HDK * HDV;
    float S[32];
#pragma unroll
    for (int i = 0; i < 32; ++i) S[i] = S0[(size_t)(dg * 32 + i) * HDV + v];
#pragma unroll
    for (int e = 0; e < 2; ++e) { const int idx = tid + 512 * e, t = idx >> 7, c = idx & 127; const size_t row = (size_t)(MP + s * SL + t);
        Fd[idx] = __expf(G[row * 1024 + h * HDK + c]); Qd[idx] = bf2f(U[row * NIN + C_HQ + h * HDK + c]); Iv[idx] = bf2f(U[row * NIN + C_HI + h * HDV + c]); Gv[idx] = bf2f(U[row * NIN + C_HGATE + h * HDV + c]); }
    const float nw = a.in[12][v];
    HG_LBAR();
    for (int t = 0; t < SL; ++t) {
        const float iv = Iv[t * 128 + v];
        float part = 0.f;
#pragma unroll
        for (int i4 = 0; i4 < 8; ++i4) { const f32x4 f4 = *(const LAS f32x4*)(Fd + t * 128 + dg * 32 + 4 * i4), q4 = *(const LAS f32x4*)(Qd + t * 128 + dg * 32 + 4 * i4);
#pragma unroll
            for (int e = 0; e < 4; ++e) { const int i = 4 * i4 + e; S[i] = f4[e] * S[i] + (1.0f - f4[e]) * iv; part += S[i] * q4[e]; } }
        red[dg * 128 + v] = part; HG_LBAR();
        const float o = (red[v] + red[128 + v]) + (red[256 + v] + red[384 + v]);
        if (dg == 0) { const float ss = wave_sum(o * o); if (lane == 0) red2[wave] = ss; }
        HG_LBAR();
        if (dg == 0) { const float rstd = 1.0f / sqrtf((red2[0] + red2[1]) * (1.0f / HDV) + RMS_EPS);
            OHG[(size_t)(MP + s * SL + t) * OPITCH + h * HDV + v] = (bf16)f2bf(o * rstd * nw * Gv[t * 128 + v]); }
    }
#pragma unroll
    for (int i = 0; i < 32; ++i) Sout[(size_t)(dg * 32 + i) * HDV + v] = S[i];
    HG_LBAR();
}
}
namespace at {
typedef short bf16x8 __attribute__((ext_vector_type(8)));
typedef short s16x4 __attribute__((ext_vector_type(4)));
typedef float f32x4 __attribute__((ext_vector_type(4)));
typedef unsigned u32x2 __attribute__((ext_vector_type(2)));
typedef unsigned u32x4 __attribute__((ext_vector_type(4)));
constexpr int KP = 144, VP = 288;
constexpr int K_BYTES = 64 * KP, V_BYTES = 64 * VP, STG = 2 * K_BYTES + V_BYTES;
constexpr int LUT = 2 * STG, WSC = LUT + 1024, LDS_END = WSC + 8 * 256;
static_assert(LDS_END <= 131072, "attention LDS map");
constexpr float NEG = -1e30f;
using hg::pkbf; using hg::trd; using hg::lo2f; using hg::hi2f;

__device__ __forceinline__ float gmax4(float x) {
    auto a = __builtin_amdgcn_permlane16_swap(__float_as_uint(x), __float_as_uint(x), false, false); x = fmaxf(__uint_as_float(a[0]), __uint_as_float(a[1]));
    auto b = __builtin_amdgcn_permlane32_swap(__float_as_uint(x), __float_as_uint(x), false, false); return fmaxf(__uint_as_float(b[0]), __uint_as_float(b[1]));
}
__device__ __forceinline__ void prompt_unit(LAS unsigned char* lds, const Args& a, int b, int h, int qb, float lam) {
    int tid = threadIdx.x; asm volatile("" : "+v"(tid));
    const int lane = tid & 63, w = __builtin_amdgcn_readfirstlane(tid >> 6), Q = lane >> 4, li = lane & 15;
    const bf16* U = (const bf16*)(a.ws + WS_U); bf16* ODA = (bf16*)(a.ws + WS_ODA);
    const size_t rbase = (size_t)b * PL;
    const int r0 = 128 * qb + 16 * w;
    const int NT = 2 * qb + 2;
    if (tid < 256) { const int mp = tid >> 7, d = tid & 127; ((LAS float*)(lds + LUT))[tid] = a.in[18][t5_bucket(d) * 16 + mp * 8 + h] * LOG2E; }
    const float c31a = a.in[18][31 * 16 + h] * LOG2E, c31b = a.in[18][31 * 16 + 8 + h] * LOG2E;
    bf16x8 qf[2][2];
#pragma unroll
    for (int mp = 0; mp < 2; ++mp)
#pragma unroll
        for (int ks = 0; ks < 2; ++ks) qf[mp][ks] = *(const bf16x8*)(U + (rbase + r0 + li) * NIN + C_DQ + (mp * 8 + h) * 64 + 32 * ks + 8 * Q);
    f32x4 OT[2][8];
#pragma unroll
    for (int mp = 0; mp < 2; ++mp)
#pragma unroll
        for (int vt = 0; vt < 8; ++vt) OT[mp][vt] = (f32x4){0.f, 0.f, 0.f, 0.f};
    float mref[2] = {0.f, 0.f};
    f32x4 LT[2] = {(f32x4){0.f, 0.f, 0.f, 0.f}, (f32x4){0.f, 0.f, 0.f, 0.f}};
    const bf16x8 ones = (bf16x8){0x3f80, 0x3f80, 0x3f80, 0x3f80, 0x3f80, 0x3f80, 0x3f80, 0x3f80};
    u32x4 st[4];
    const int srow = tid >> 3, sch = tid & 7;
#define AT_LOAD(t) do { const bf16* rp = U + (rbase + (size_t)(t) * 64 + srow) * NIN; \
        st[0] = *(const u32x4*)(rp + C_DK + h * 64 + sch * 8); st[1] = *(const u32x4*)(rp + C_DK + (8 + h) * 64 + sch * 8); \
        st[2] = *(const u32x4*)(rp + C_DV + h * 128 + sch * 16); st[3] = *(const u32x4*)(rp + C_DV + h * 128 + sch * 16 + 8); } while (0)
#define AT_STORE(buf) do { LAS unsigned char* sb = lds + (buf) * STG; \
        *(LAS u32x4*)(sb + srow * KP + sch * 16) = st[0]; *(LAS u32x4*)(sb + K_BYTES + srow * KP + sch * 16) = st[1]; \
        *(LAS u32x4*)(sb + 2 * K_BYTES + srow * VP + sch * 32) = st[2]; *(LAS u32x4*)(sb + 2 * K_BYTES + srow * VP + sch * 32 + 16) = st[3]; } while (0)
    AT_LOAD(0); AT_STORE(0);
    HG_LBAR();
    for (int t = 0; t < NT; ++t) {
        if (t + 1 < NT) AT_LOAD(t + 1);
        const int k0 = 64 * t;
        if (k0 <= r0 + 15) {
            const LAS unsigned char* sb = lds + (t & 1) * STG;
            const bool far = (r0 - (k0 + 63)) >= 113;
            u32x4 pb[2][2];
#pragma unroll
            for (int mp = 0; mp < 2; ++mp) {
                const float cinit = (far ? (mp ? c31b : c31a) : 0.f) - mref[mp];
                f32x4 s[4];
#pragma unroll
                for (int i = 0; i < 4; ++i) { s[i] = (f32x4){cinit, cinit, cinit, cinit};
#pragma unroll
                    for (int ks = 0; ks < 2; ++ks) { const bf16x8 kf = *(const LAS bf16x8*)(sb + mp * K_BYTES + (16 * i + li) * KP + (32 * ks + 8 * Q) * 2);
                        s[i] = __builtin_amdgcn_mfma_f32_16x16x32_bf16(kf, qf[mp][ks], s[i], 0, 0, 0); } }
                if (!far) {
                    const LAS float* lut = (const LAS float*)(lds + LUT) + mp * 128;
#pragma unroll
                    for (int i = 0; i < 4; ++i)
#pragma unroll
                        for (int r = 0; r < 4; ++r) { const int dist = (r0 + li) - (k0 + 16 * i + 4 * Q + r); const int di = dist < 0 ? 0 : (dist > 127 ? 127 : dist);
                            const float v = s[i][r] + lut[di]; s[i][r] = dist < 0 ? NEG : v; }
                }
                float mx = fmaxf(fmaxf(fmaxf(s[0][0], s[0][1]), fmaxf(s[0][2], s[0][3])), fmaxf(fmaxf(s[1][0], s[1][1]), fmaxf(s[1][2], s[1][3])));
                mx = fmaxf(mx, fmaxf(fmaxf(fmaxf(s[2][0], s[2][1]), fmaxf(s[2][2], s[2][3])), fmaxf(fmaxf(s[3][0], s[3][1]), fmaxf(s[3][2], s[3][3]))));
                mx = gmax4(mx);
                const float delta = (t == 0) ? mx : fmaxf(mx, 0.f);
                if (__any(delta != 0.f)) {
                    const float alpha = __builtin_amdgcn_exp2f(-delta); mref[mp] += delta;
#pragma unroll
                    for (int i = 0; i < 4; ++i) s[i] = s[i] - delta;
#pragma unroll
                    for (int vt = 0; vt < 8; ++vt) OT[mp][vt] = OT[mp][vt] * alpha;
                    LT[mp] = LT[mp] * alpha; }
#pragma unroll
                for (int i = 0; i < 4; ++i)
#pragma unroll
                    for (int r = 0; r < 4; ++r) s[i][r] = __builtin_amdgcn_exp2f(s[i][r]);
                pb[mp][0] = (u32x4){pkbf(s[0][0], s[0][1]), pkbf(s[0][2], s[0][3]), pkbf(s[1][0], s[1][1]), pkbf(s[1][2], s[1][3])};
                pb[mp][1] = (u32x4){pkbf(s[2][0], s[2][1]), pkbf(s[2][2], s[2][3]), pkbf(s[3][0], s[3][1]), pkbf(s[3][2], s[3][3])};
                LT[mp] = __builtin_amdgcn_mfma_f32_16x16x32_bf16(ones, __builtin_bit_cast(bf16x8, pb[mp][0]), LT[mp], 0, 0, 0);
                LT[mp] = __builtin_amdgcn_mfma_f32_16x16x32_bf16(ones, __builtin_bit_cast(bf16x8, pb[mp][1]), LT[mp], 0, 0, 0);
            }
            const LAS unsigned char* vb = sb + 2 * K_BYTES;
#pragma unroll
            for (int T = 0; T < 2; ++T)
#pragma unroll
                for (int vt = 0; vt < 8; ++vt) { const LAS unsigned char* vp = vb + (32 * T + 4 * Q + (li >> 2)) * VP + (16 * vt + 4 * (li & 3)) * 2;
                    const s16x4 lo = trd(vp), hi = trd(vp + 16 * VP); const bf16x8 vf = (bf16x8){lo[0], lo[1], lo[2], lo[3], hi[0], hi[1], hi[2], hi[3]};
                    OT[0][vt] = __builtin_amdgcn_mfma_f32_16x16x32_bf16(vf, __builtin_bit_cast(bf16x8, pb[0][T]), OT[0][vt], 0, 0, 0);
                    OT[1][vt] = __builtin_amdgcn_mfma_f32_16x16x32_bf16(vf, __builtin_bit_cast(bf16x8, pb[1][T]), OT[1][vt], 0, 0, 0); }
        }
        if (t + 1 < NT) AT_STORE((t + 1) & 1);
        HG_LBAR();
    }
#undef AT_LOAD
#undef AT_STORE
    const float l0 = LT[0][0], l1 = LT[1][0];
    const float i0 = 1.0f / l0, i1 = lam / l1; float ss = 0.f;
#pragma unroll
    for (int vt = 0; vt < 8; ++vt) { OT[0][vt] = OT[0][vt] * i0 - OT[1][vt] * i1; ss += (OT[0][vt][0] * OT[0][vt][0] + OT[0][vt][1] * OT[0][vt][1]) + (OT[0][vt][2] * OT[0][vt][2] + OT[0][vt][3] * OT[0][vt][3]); }
    ss += __shfl_xor(ss, 16); ss += __shfl_xor(ss, 32);
    const float rstd = (1.0f - LAM_INIT) / sqrtf(ss * (1.0f / DADV) + RMS_EPS);
    bf16* op = ODA + (rbase + r0 + li) * OPITCH + h * DADV + 4 * Q;
#pragma unroll
    for (int vt = 0; vt < 8; ++vt) { const f32x4 wv = *(const f32x4*)(a.in[17] + 16 * vt + 4 * Q); const f32x4 o = OT[0][vt] * rstd * wv;
        *(u32x2*)(op + 16 * vt) = (u32x2){pkbf(o[0], o[1]), pkbf(o[2], o[3])}; }
}
}
namespace dc {
typedef short bf16x8 __attribute__((ext_vector_type(8)));
typedef short s16x4 __attribute__((ext_vector_type(4)));
typedef float f32x4 __attribute__((ext_vector_type(4)));
typedef unsigned u32x2 __attribute__((ext_vector_type(2)));
typedef unsigned u32x4 __attribute__((ext_vector_type(4)));
constexpr int NPG = 4, NSPLIT = NPAGES / NPG, SPW = NSPLIT / 8;
constexpr int VP = 288, WREG = 32 * VP, FLAG = 8 * WREG, LDS_END = FLAG + 64;
constexpr size_t PM_OFF = 0, PL_OFF = (size_t)SB * NH * 16 * NSPLIT * 4, PO_OFF = 2 * PL_OFF, PO_BYTES = (size_t)SB * NSPLIT * NH * 16 * 128 * 4;
static_assert(WS_DEC + PO_OFF + PO_BYTES <= WS_END && LDS_END <= 131072, "decode maps");
constexpr float NEG = -1e30f;
using hg::pkbf; using hg::trd;
__device__ __forceinline__ f32x4 ldnt(const float* p) { return __builtin_nontemporal_load((const f32x4*)p); }

__device__ __forceinline__ void combine_task(LAS unsigned char* lds, const Args& a, gu32* cnt, int s, int h, float lam) {
    int tid = threadIdx.x; asm volatile("" : "+v"(tid));
    const int lane = tid & 63, w = __builtin_amdgcn_readfirstlane(tid >> 6), Q = lane >> 4, li = lane & 15, mp = li >> 3, j = li & 7;
    if (tid < 64) { unsigned sp = 0; while ((unsigned)__builtin_amdgcn_readfirstlane((int)__hip_atomic_load(cnt + 64 * s, RLX_AGENT)) < (unsigned)NSPLIT) { __builtin_amdgcn_s_sleep(2); if (++sp > (1u << 22)) break; }
        __builtin_amdgcn_fence(__ATOMIC_ACQUIRE, "agent"); asm volatile("s_waitcnt vmcnt(0)" ::: "memory"); }
    __syncthreads();
    const bf16* U = (const bf16*)(a.ws + WS_U); bf16* ODA = (bf16*)(a.ws + WS_ODA);
    const float* PM = (const float*)(a.ws + WS_DEC + PM_OFF) + (size_t)((s * NH + h) * 16 + li) * NSPLIT; const float* PLs = (const float*)(a.ws + WS_DEC + PL_OFF) + (size_t)((s * NH + h) * 16 + li) * NSPLIT;
    const float* PO = (const float*)(a.ws + WS_DEC + PO_OFF);
    float sn[8];
    { f32x4 qv[16]; const bf16* qp = U + (size_t)(MP + s * SL + j) * NIN + C_DQ + (mp * 8 + h) * 64;
#pragma unroll
      for (int c = 0; c < 8; ++c) { const u32x4 t = *(const u32x4*)(qp + 8 * c); qv[2 * c] = (f32x4){hg::lo2f(t.x), hg::hi2f(t.x), hg::lo2f(t.y), hg::hi2f(t.y)}; qv[2 * c + 1] = (f32x4){hg::lo2f(t.z), hg::hi2f(t.z), hg::lo2f(t.w), hg::hi2f(t.w)}; }
#pragma unroll
      for (int jj = 0; jj < 8; ++jj) { const float* kp = a.out + O_KS + (size_t)(s * SL + jj) * 1024 + (mp * 8 + h) * 64; float sc = 0.f;
#pragma unroll
          for (int c = 0; c < 16; ++c) { const f32x4 kv = *(const f32x4*)(kp + 4 * c); sc += (qv[c][0] * kv[0] + qv[c][1] * kv[1]) + (qv[c][2] * kv[2] + qv[c][3] * kv[3]); }
          const int dist = j - jj; sc += a.in[18][(dist < 0 ? 0 : dist) * 16 + mp * 8 + h] * LOG2E;
          sn[jj] = dist < 0 ? NEG : sc; __builtin_amdgcn_sched_barrier(0); } }
    float mstar = NEG;
#pragma unroll
    for (int c = 0; c < NSPLIT / 4; ++c) { const f32x4 t = *(const f32x4*)(PM + 4 * c); mstar = fmaxf(mstar, fmaxf(fmaxf(t[0], t[1]), fmaxf(t[2], t[3]))); }
#pragma unroll
    for (int jj = 0; jj < 8; ++jj) mstar = fmaxf(mstar, sn[jj]);
    f32x4 acc[8]; float lsum = 0.f;
#pragma unroll
    for (int vt = 0; vt < 8; ++vt) acc[vt] = (f32x4){0.f, 0.f, 0.f, 0.f};
    static_assert(SPW * 8 == NSPLIT && SPW % 2 == 0, "8 waves x SPW splits, two at a time");
#pragma unroll 1
    for (int c = 0; c < SPW / 2; ++c) { const float m0 = PM[SPW * w + 2 * c], m1 = PM[SPW * w + 2 * c + 1], l0 = PLs[SPW * w + 2 * c], l1 = PLs[SPW * w + 2 * c + 1];
        f32x4 ov[2][8];
#pragma unroll
        for (int e = 0; e < 2; ++e) { const float* op = PO + ((((size_t)s * NSPLIT + (SPW * w + 2 * c + e)) * NH + h) * 16 + li) * 128 + 4 * Q;
#pragma unroll
            for (int vt = 0; vt < 8; ++vt) ov[e][vt] = *(const f32x4*)(op + 16 * vt); }
        const float w0 = __builtin_amdgcn_exp2f(m0 - mstar), w1 = __builtin_amdgcn_exp2f(m1 - mstar); lsum += w0 * l0 + w1 * l1;
#pragma unroll
        for (int vt = 0; vt < 8; ++vt) acc[vt] += ov[0][vt] * w0 + ov[1][vt] * w1; }
    if (w == 0) {
#pragma unroll
        for (int jj = 0; jj < 8; ++jj) { const float p = __builtin_amdgcn_exp2f(sn[jj] - mstar); lsum += p; const float* vp = a.out + O_VS + (size_t)(s * SL + jj) * 1024 + h * 128 + 4 * Q;
#pragma unroll
            for (int vt = 0; vt < 8; ++vt) acc[vt] += *(const f32x4*)(vp + 16 * vt) * p; } }
    LAS float* P = (LAS float*)lds;
#pragma unroll
    for (int vt = 0; vt < 8; ++vt)
#pragma unroll
        for (int r = 0; r < 4; ++r) P[(w * 33 + vt * 4 + r) * 64 + lane] = acc[vt][r];
    P[(w * 33 + 32) * 64 + lane] = lsum;
    HG_LBAR();
    if (w == 0) {
        lsum = 0.f;
#pragma unroll
        for (int ww = 0; ww < 8; ++ww) lsum += P[(ww * 33 + 32) * 64 + lane];
        const float sc = (mp ? -lam : 1.0f) / lsum; float ss = 0.f;
#pragma unroll
        for (int vt = 0; vt < 8; ++vt) { f32x4 o;
#pragma unroll
            for (int r = 0; r < 4; ++r) { float t = 0.f;
#pragma unroll
                for (int ww = 0; ww < 8; ++ww) t += P[(ww * 33 + vt * 4 + r) * 64 + lane];
                t *= sc; t += __shfl_xor(t, 8); o[r] = t; }
            acc[vt] = o; ss += (o[0] * o[0] + o[1] * o[1]) + (o[2] * o[2] + o[3] * o[3]); }
        ss += __shfl_xor(ss, 16); ss += __shfl_xor(ss, 32);
        const float rstd = (1.0f - LAM_INIT) / sqrtf(ss * (1.0f / DADV) + RMS_EPS);
        if (mp == 0) { bf16* op = ODA + (size_t)(MP + s * SL + j) * OPITCH + h * DADV + 4 * Q;
#pragma unroll
            for (int vt = 0; vt < 8; ++vt) { const f32x4 wv = *(const f32x4*)(a.in[17] + 16 * vt + 4 * Q); const f32x4 o = acc[vt] * rstd * wv; *(u32x2*)(op + 16 * vt) = (u32x2){pkbf(o[0], o[1]), pkbf(o[2], o[3])}; } }
    }
    HG_LBAR();
}

__device__ __forceinline__ void unit(LAS unsigned char* lds, const Args& a, gu32* cnt, int s, int g, float lam) {
    int tid = threadIdx.x; asm volatile("" : "+v"(tid));
    const int lane = tid & 63, h = __builtin_amdgcn_readfirstlane(tid >> 6), Q = lane >> 4, li = lane & 15, mp = li >> 3, j = li & 7;
    const bf16* U = (const bf16*)(a.ws + WS_U);
    LAS unsigned char* wreg = lds + h * WREG;
    const float c31 = a.in[18][31 * 16 + mp * 8 + h] * LOG2E;
    bf16x8 qf[2];
#pragma unroll
    for (int ks = 0; ks < 2; ++ks) qf[ks] = *(const bf16x8*)(U + (size_t)(MP + s * SL + j) * NIN + C_DQ + (mp * 8 + h) * 64 + 32 * ks + 8 * Q);
    f32x4 OT[8];
#pragma unroll
    for (int vt = 0; vt < 8; ++vt) OT[vt] = (f32x4){0.f, 0.f, 0.f, 0.f};
    float mrun = NEG, lrun = 0.f;
#pragma unroll 1
    for (int pg = 0; pg < NPG; ++pg) {
        const int lp = g * NPG + pg, page = a.page_table[s * NPAGES + lp];
        const __amdgpu_buffer_rsrc_t krs = __builtin_amdgcn_make_buffer_rsrc((void*)(a.in[2] + (size_t)page * PAGE * 1024), 0, PAGE * 1024 * 4, 0x00020000);
        const __amdgpu_buffer_rsrc_t vrs = __builtin_amdgcn_make_buffer_rsrc((void*)(a.in[3] + (size_t)page * PAGE * 1024), 0, PAGE * 1024 * 4, 0x00020000);
        const int kvo = ((lane >> 4) * 1024 + h * 64 + (lane & 15) * 4) * 4;
        const int vvo = ((lane >> 5) * 1024 + h * 128 + (lane & 31) * 4) * 4;
        f32x4 kr[8];
#define DC_LD(rs, vo, so) __builtin_bit_cast(f32x4, __builtin_amdgcn_raw_buffer_load_b128(rs, vo, so, 0))
#define DC_KLOAD(dst, i) do { const int so_ = 16 * (i) * 4096; \
            dst[0] = DC_LD(krs, kvo, so_); dst[1] = DC_LD(krs, kvo, so_ + 4 * 4096); dst[2] = DC_LD(krs, kvo, so_ + 8 * 4096); dst[3] = DC_LD(krs, kvo, so_ + 12 * 4096); \
            dst[4] = DC_LD(krs, kvo, so_ + 2048); dst[5] = DC_LD(krs, kvo, so_ + 4 * 4096 + 2048); dst[6] = DC_LD(krs, kvo, so_ + 8 * 4096 + 2048); dst[7] = DC_LD(krs, kvo, so_ + 12 * 4096 + 2048); } while (0)
        constexpr int KRP = 144, KMAP = 16 * KRP, KSLAB = 2 * KMAP; static_assert(2 * KSLAB <= WREG, "K slabs inside the wave's V stage");
        LAS unsigned char* kwr = wreg + (lane >> 4) * KRP + (lane & 15) * 8; const LAS unsigned char* kfr = wreg + li * KRP + 16 * Q;
#define DC_KPARK(src, i) do { _Pragma("unroll") for (int n_ = 0; n_ < 8; ++n_) *(LAS u32x2*)(kwr + ((i) & 1) * KSLAB + (n_ >> 2) * KMAP + 4 * (n_ & 3) * KRP) = (u32x2){pkbf(src[n_][0], src[n_][1]), pkbf(src[n_][2], src[n_][3])}; } while (0)
#define DC_KF(i, m, ks) (*(const LAS bf16x8*)(kfr + ((i) & 1) * KSLAB + (m) * KMAP + 64 * (ks)))
        f32x4 S[8];
        DC_KLOAD(kr, 0);
#pragma unroll
        for (int i = 0; i < 8; ++i) {
            DC_KPARK(kr, i);
            if (i + 1 < 8) DC_KLOAD(kr, i + 1);
            asm volatile("s_waitcnt lgkmcnt(0)" ::: "memory");
            const bf16x8 k00 = DC_KF(i, 0, 0), k01 = DC_KF(i, 0, 1), k10 = DC_KF(i, 1, 0), k11 = DC_KF(i, 1, 1);
            const f32x4 z = (f32x4){0.f, 0.f, 0.f, 0.f};
            f32x4 t1 = __builtin_amdgcn_mfma_f32_16x16x32_bf16(k00, qf[0], z, 0, 0, 0); t1 = __builtin_amdgcn_mfma_f32_16x16x32_bf16(k01, qf[1], t1, 0, 0, 0);
            f32x4 t2 = __builtin_amdgcn_mfma_f32_16x16x32_bf16(k10, qf[0], z, 0, 0, 0); t2 = __builtin_amdgcn_mfma_f32_16x16x32_bf16(k11, qf[1], t2, 0, 0, 0);
            S[i] = mp ? t2 : t1;
            __builtin_amdgcn_sched_barrier(0);
        }
        f32x4 vr[16];
#define DC_VLOAD(T) do { _Pragma("unroll") for (int n_ = 0; n_ < 16; ++n_) vr[n_] = DC_LD(vrs, vvo, (32 * (T) + 2 * n_) * 4096); } while (0)
        DC_VLOAD(0);
        if (lp == NPAGES - 1) {
#pragma unroll
            for (int i = 0; i < 8; ++i)
#pragma unroll
                for (int r = 0; r < 4; ++r) { const int dist = PAST + j - (lp * PAGE + 16 * i + 4 * Q + r); S[i][r] += a.in[18][t5_bucket(dist) * 16 + mp * 8 + h] * LOG2E; }
        } else {
#pragma unroll
            for (int i = 0; i < 8; ++i) S[i] = S[i] + c31;
        }
        float mx = NEG;
#pragma unroll
        for (int i = 0; i < 8; ++i) mx = fmaxf(mx, fmaxf(fmaxf(S[i][0], S[i][1]), fmaxf(S[i][2], S[i][3])));
        mx = fmaxf(mx, __shfl_xor(mx, 16)); mx = fmaxf(mx, __shfl_xor(mx, 32));
        const float mn = fmaxf(mrun, mx), alpha = __builtin_amdgcn_exp2f(mrun - mn); mrun = mn;
        float ps = 0.f;
#pragma unroll
        for (int i = 0; i < 8; ++i)
#pragma unroll
            for (int r = 0; r < 4; ++r) { S[i][r] = __builtin_amdgcn_exp2f(S[i][r] - mn); ps += S[i][r]; }
        lrun = lrun * alpha + ps;
#pragma unroll
        for (int vt = 0; vt < 8; ++vt) OT[vt] = OT[vt] * alpha;
#pragma unroll
        for (int T = 0; T < 4; ++T) {
#pragma unroll
            for (int n = 0; n < 16; ++n) *(LAS u32x2*)(wreg + (2 * n + (lane >> 5)) * VP + (lane & 31) * 8) = (u32x2){pkbf(vr[n][0], vr[n][1]), pkbf(vr[n][2], vr[n][3])};
            if (T + 1 < 4) DC_VLOAD(T + 1);
            asm volatile("s_waitcnt lgkmcnt(0)" ::: "memory");
            const bf16x8 pb = __builtin_bit_cast(bf16x8, (u32x4){pkbf(S[2 * T][0], S[2 * T][1]), pkbf(S[2 * T][2], S[2 * T][3]), pkbf(S[2 * T + 1][0], S[2 * T + 1][1]), pkbf(S[2 * T + 1][2], S[2 * T + 1][3])});
#pragma unroll
            for (int vt = 0; vt < 8; ++vt) { const LAS unsigned char* vp = wreg + (4 * Q + (li >> 2)) * VP + (16 * vt + 4 * (li & 3)) * 2;
                const s16x4 lo = trd(vp), hi = trd(vp + 16 * VP); const bf16x8 vf = (bf16x8){lo[0], lo[1], lo[2], lo[3], hi[0], hi[1], hi[2], hi[3]};
                OT[vt] = __builtin_amdgcn_mfma_f32_16x16x32_bf16(vf, pb, OT[vt], 0, 0, 0); if ((vt & 3) == 3) __builtin_amdgcn_sched_barrier(0); }
            asm volatile("s_waitcnt lgkmcnt(0)" ::: "memory");
            __builtin_amdgcn_sched_barrier(0);
        }
#undef DC_KLOAD
#undef DC_LD
#undef DC_KF
#undef DC_KPARK
#undef DC_VLOAD
    }
    lrun += __shfl_xor(lrun, 16); lrun += __shfl_xor(lrun, 32);
    if (Q == 0) { const size_t o = (size_t)((s * NH + h) * 16 + li) * NSPLIT + g;
        __hip_atomic_store((gu32*)(a.ws + WS_DEC + PM_OFF) + o, __float_as_uint(mrun), RLX_AGENT); __hip_atomic_store((gu32*)(a.ws + WS_DEC + PL_OFF) + o, __float_as_uint(lrun), RLX_AGENT); }
    { const __amdgpu_buffer_rsrc_t rs = __builtin_amdgcn_make_buffer_rsrc(a.ws + WS_DEC + PO_OFF, 0, (int)PO_BYTES, 0x00020000);
      const unsigned off = (unsigned)((((((size_t)s * NSPLIT + g) * NH + h) * 16 + li) * 128 + 4 * Q) * 4);
#pragma unroll
      for (int vt = 0; vt < 8; ++vt) __builtin_amdgcn_raw_buffer_store_b128(__builtin_bit_cast(u32x4, OT[vt]), rs, off + 64 * vt, 0, 16); }
    asm volatile("s_waitcnt vmcnt(0)" ::: "memory");
    __syncthreads();
    if (tid == 0) (void)__hip_atomic_fetch_add(cnt + 64 * s, 1u, RLX_AGENT);
}
}
namespace th {
typedef short bf16x8 __attribute__((ext_vector_type(8)));
typedef float f32x4 __attribute__((ext_vector_type(4)));
typedef unsigned u32x4_t __attribute__((ext_vector_type(4)));
template <int K>
__device__ __forceinline__ void stream_gemm(LAS unsigned char* slab, const bf16* X, const bf16* W, int ld, int row0, int n0, int w, int lane, f32x4 (&acc)[2]) {
    constexpr int NG = K / 128, RP = 272; static_assert(NG * 128 == K, "K in groups of 128");
    const int r = lane >> 4, c = lane & 15, li = lane & 15, Q = lane >> 4;
    const GAS unsigned char* wb = (const GAS unsigned char*)(W + (size_t)(n0 + r) * ld) + 16 * c;
    const GAS unsigned char* xb = (const GAS unsigned char*)(X + (size_t)(row0 + r) * ld) + 16 * c;
    const size_t rs4 = (size_t)ld * 8;
    LAS unsigned char* wr = slab + r * RP + 16 * c;
    const LAS unsigned char* fa = slab + li * RP + 16 * Q;
    u32x4_t t[12];
    int g = w;
    if (g < NG) {
#pragma unroll
        for (int j = 0; j < 12; ++j) t[j] = *(const GAS u32x4_t*)((j < 4 ? wb + j * rs4 : xb + (j - 4) * rs4) + (size_t)g * 256);
    }
#pragma unroll 1
    for (; g < NG; g += 8) {
#pragma unroll
        for (int j = 0; j < 12; ++j) *(LAS u32x4_t*)(wr + 4 * j * RP) = t[j];
        if (g + 8 < NG) {
#pragma unroll
            for (int j = 0; j < 12; ++j) t[j] = *(const GAS u32x4_t*)((j < 4 ? wb + j * rs4 : xb + (j - 4) * rs4) + (size_t)(g + 8) * 256);
        }
        asm volatile("s_waitcnt lgkmcnt(0)" ::: "memory");
        bf16x8 af[4], b0[4], b1[4];
#pragma unroll
        for (int s = 0; s < 4; ++s) { af[s] = *(const LAS bf16x8*)(fa + 64 * s); b0[s] = *(const LAS bf16x8*)(fa + 16 * RP + 64 * s); b1[s] = *(const LAS bf16x8*)(fa + 32 * RP + 64 * s); }
#pragma unroll
        for (int s = 0; s < 4; ++s) { acc[0] = __builtin_amdgcn_mfma_f32_16x16x32_bf16(af[s], b0[s], acc[0], 0, 0, 0); acc[1] = __builtin_amdgcn_mfma_f32_16x16x32_bf16(af[s], b1[s], acc[1], 0, 0, 0); }
        asm volatile("s_waitcnt lgkmcnt(0)" ::: "memory");
    }
}
template <int K, int NACC, class Epi>
__device__ __forceinline__ void tile(LAS unsigned char* lds, const bf16* X1, const bf16* W1, const bf16* X2, const bf16* W2, int row0, int n0, const Epi& E, int ld = K) {
    int tid = threadIdx.x; asm volatile("" : "+v"(tid));
    const int lane = tid & 63, w = __builtin_amdgcn_readfirstlane(tid >> 6), li = lane & 15, Q = lane >> 4;
    f32x4 acc[NACC][2];
#pragma unroll
    for (int g = 0; g < NACC; ++g)
#pragma unroll
        for (int mt = 0; mt < 2; ++mt) acc[g][mt] = (f32x4){0.f, 0.f, 0.f, 0.f};
    LAS unsigned char* slab = lds + w * (48 * 272);
    stream_gemm<K>(slab, X1, W1, ld, row0, n0, w, lane, acc[0]);
    if constexpr (NACC == 2) stream_gemm<K>(slab, X2, W2, ld, row0, n0, w, lane, acc[1]);
    HG_LBAR();
    LAS float* P = (LAS float*)lds;
#pragma unroll
    for (int g = 0; g < NACC; ++g)
#pragma unroll
        for (int mt = 0; mt < 2; ++mt)
#pragma unroll
            for (int r = 0; r < 4; ++r) P[(w * NACC * 8 + g * 8 + mt * 4 + r) * 64 + lane] = acc[g][mt][r];
    HG_LBAR();
    const int mt = w >> 2, r0 = w & 3;
    float v[NACC];
#pragma unroll
    for (int g = 0; g < NACC; ++g) { float s = 0.f;
#pragma unroll
        for (int ww = 0; ww < 8; ++ww) s += P[(ww * NACC * 8 + g * 8 + mt * 4 + r0) * 64 + lane];
        v[g] = s; }
    E(row0 + 16 * mt + li, n0 + 4 * Q + r0, v[0], v[NACC - 1]);
    HG_LBAR();
}
}
constexpr int N_PHASES = 9;
#if 0
#define PROBE_PHASE_UNUSED -1
#endif
#define REP(k) for (int rp_ = 0; rp_ < ((PROBE_PHASE == (k)) ? 2 : 1); ++rp_)
#define PROBE_MUL(k) ((PROBE_PHASE == (k) || PROBE_PHASE == 29) ? 2 : 1)
#define REPBAR(k) do { if (PROBE_PHASE == (k) && rp_ == 0) GRID_BAR(); } while (0)
__global__ void __launch_bounds__(NWAVES * 64, 2) mk_fwd(Args args) {
    extern __shared__ __attribute__((aligned(16))) unsigned char lds[];
    Frame F;
    F.lds = (LAS unsigned char*)lds; F.MISC = (volatile LAS unsigned*)(F.lds + MISC_OFF);
    F.tid = threadIdx.x; F.lane = F.tid & 63; F.wave = __builtin_amdgcn_readfirstlane(F.tid >> 6);
    F.G = gridDim.x; { const int bx = blockIdx.x; F.vcu = (F.G % 8 == 0) ? (bx % 8) * (F.G / 8) + bx / 8 : bx; }
    unsigned char* ws = args.ws;
    F.ctl = (gu32*)(ws + WS_CTL);
    for (int u = F.tid; u < (LDS_BYTES - LDSCTL_OFF) / 4; u += NWAVES * 64) ((LAS unsigned*)(F.lds + LDSCTL_OFF))[u] = 0u;
    __syncthreads();
    const int lo = args.ph_lo, hi = args.ph_hi;
    XcdBarrier bar = xcd_barrier_post((unsigned*)(F.ctl + CW_BAR) + lo * XCD_BAR_WORDS, F.MISC + 8);
#define IN(k) (lo <= (k) && (k) < hi)
#define BOTH(k) (IN(k) && IN((k) + 1))
#define GRID_BAR() xcd_barrier(bar)
    if (IN(0)) REP(0) { p0_prologue(F, args); REPBAR(0); if (BOTH(0)) GRID_BAR(); }
    if (IN(1)) REP(1) {
        pg8::Gemm g{(const bf16*)(ws + WS_XN), (const bf16*)(ws + WS_WIN), MT, NIN, DM}; pg8::StaticOrder S; S.init(MT, NIN, F.G, (int)blockIdx.x);
        pg8::EpiInProj E{(bf16*)(ws + WS_U), (float*)(ws + WS_G), args.out + O_KP, args.out + O_VP, args.out + O_KS, args.out + O_VS, args.in[11], NIN, MP, MREAL, QSCALE};
        pg8::gemm_phase<pg8::EpiInProj, pg8::StaticOrder, true, true>(F.lds + RING_OFF, g, S, E);
        if (rp_ == 0) convert_late(F, args, F.ctl + CW_Q + 32);
        REPBAR(1); if (BOTH(1)) GRID_BAR();
    }
    if (PROBE_PHASE == 30) { for (int i = 0; i < 16; ++i) GRID_BAR(); }
    if (IN(2)) REP(2) {
        const float lam = da_lambda(args);
#define QPOP(word) ({ if (F.tid == 0) F.MISC[0] = __hip_atomic_fetch_add(F.ctl + (word), 1u, RLX_AGENT); __syncthreads(); const int u_ = __builtin_amdgcn_readfirstlane((int)F.MISC[0]); __syncthreads(); u_; })
        const bool roleA = (((blockIdx.x >> 3) & 1) == 0) || F.G < 128;
        if ((args.p2mask & 1) && roleA) for (;;) { const int u = QPOP(CW_Q + 256 * rp_); if (u >= PB * NH * PROBE_MUL(20)) break; hg::prompt_unit(F.lds + RING_OFF, args, (u % (PB * NH)) / NH, u % NH); }
        if ((args.p2mask & 8) && roleA) for (;;) { const int u = QPOP(CW_Q + 192 + 256 * rp_); if (u >= SB * NH) break; hg::sample_unit(F.lds + RING_OFF, args, u / NH, u % NH); }
        if ((args.p2mask & 2) && ((blockIdx.x >> 3) & 1)) for (;;) { const int u = QPOP(CW_Q + 64 + 256 * rp_); if (u >= SB * dc::NSPLIT * PROBE_MUL(21)) break; const int uu = u % (SB * dc::NSPLIT), rr = u / (SB * dc::NSPLIT);
                   dc::unit(F.lds + RING_OFF, args, F.ctl + CW_DCNT + 512 * (rp_ + rr), uu / dc::NSPLIT, uu % dc::NSPLIT, lam); }
        if (args.p2mask & 4) for (;;) { const int u = QPOP(CW_Q + 128 + 256 * rp_); if (u >= PB * DAH * 16 * PROBE_MUL(22)) break; const int uu = u % (PB * DAH * 16), qb = 15 - (uu >> 5), bh = uu & 31; at::prompt_unit(F.lds + RING_OFF, args, bh / DAH, bh % DAH, qb, lam); }
        if (args.p2mask & 2) for (;;) { const int u = QPOP(CW_Q + 64 + 256 * rp_); if (u >= SB * dc::NSPLIT * PROBE_MUL(21)) break; const int uu = u % (SB * dc::NSPLIT), rr = u / (SB * dc::NSPLIT);
                   dc::unit(F.lds + RING_OFF, args, F.ctl + CW_DCNT + 512 * (rp_ + rr), uu / dc::NSPLIT, uu % dc::NSPLIT, lam); }
        if (args.p2mask & 2) for (;;) { const int u = QPOP(CW_Q + 224 + 256 * rp_); if (u >= SB * NH * PROBE_MUL(21)) break; const int uu = u % (SB * NH), rr = u / (SB * NH);
                   dc::combine_task(F.lds + RING_OFF, args, F.ctl + CW_DCNT + 512 * (rp_ + rr), uu / NH, uu % NH, lam); }
#undef QPOP
        REPBAR(2); if (BOTH(2)) GRID_BAR();
    }
    if (IN(3)) REP(3) {
        { pg8::Gemm g{(const bf16*)(ws + WS_OHG), (const bf16*)(ws + WS_WBH), MP, DM, OPITCH}; pg8::StaticOrder S; S.init(MP, DM, F.G, (int)blockIdx.x, 4);
          pg8::EpiBranchCat E{(const bf16*)(ws + WS_U) + C_GHG, (const bf16*)(ws + WS_U) + C_GDA, NIN, (bf16*)(ws + WS_MIX)};
          pg8::gemm_phase<pg8::EpiBranchCat, pg8::StaticOrder, true, true>(F.lds + RING_OFF, g, S, E); }
        for (int tn = (int)blockIdx.x; tn < 2 * (DM / 16); tn += F.G) {
            const bf16* Ub = (const bf16*)(ws + WS_U); bf16* MIX = (bf16*)(ws + WS_MIX);
            auto E = [=](int tok, int n, float a, float b) { const size_t row = (size_t)(MP + tok);
                MIX[row * DM + n] = (bf16)f2bf(bf2f(Ub[row * NIN + C_GHG + n]) * a + bf2f(Ub[row * NIN + C_GDA + n]) * b); };
            th::tile<1024, 2>(F.lds + RING_OFF, (const bf16*)(ws + WS_OHG) + (size_t)MP * OPITCH, (const bf16*)(ws + WS_WBH), (const bf16*)(ws + WS_ODA) + (size_t)MP * OPITCH, (const bf16*)(ws + WS_WBD), 32 * (tn & 1), 16 * (tn >> 1), E, OPITCH);
        }
        REPBAR(3); if (BOTH(3)) GRID_BAR();
    }
    if (IN(4)) REP(4) {
        pg8::Gemm g{(const bf16*)(ws + WS_MIX), (const bf16*)(ws + WS_WOUT), MP, DM, DM}; pg8::StaticOrder S; S.init(MP, DM, F.G, (int)blockIdx.x, 4);
        pg8::EpiBf16Plain E{(bf16*)(ws + WS_Y1), DM};
        pg8::gemm_phase<pg8::EpiBf16Plain, pg8::StaticOrder, true, true>(F.lds + RING_OFF, g, S, E);
        for (int tn = (int)blockIdx.x; tn < 2 * (DM / 16); tn += F.G) {
            bf16* Y = (bf16*)(ws + WS_Y1);
            auto Et = [=](int tok, int n, float a, float) { Y[(size_t)(MP + tok) * DM + n] = (bf16)f2bf(a); };
            th::tile<DM, 1>(F.lds + RING_OFF, (const bf16*)(ws + WS_MIX) + (size_t)MP * DM, (const bf16*)(ws + WS_WOUT), nullptr, nullptr, 32 * (tn & 1), 16 * (tn >> 1), Et);
        }
        REPBAR(4); if (BOTH(4)) GRID_BAR();
    }
    if (IN(5)) REP(5) { row_pass1(F, args); REPBAR(5); if (BOTH(5)) GRID_BAR(); }
    if (IN(6)) REP(6) {
        pg8::Gemm g{(const bf16*)(ws + WS_XN2), (const bf16*)(ws + WS_WUP), MT, NIN, DM}; pg8::StaticOrder S; S.init(MT, NIN, F.G, (int)blockIdx.x);
        pg8::EpiSwiGLU E{(bf16*)(ws + WS_HID), DFF};
        pg8::gemm_phase<pg8::EpiSwiGLU, pg8::StaticOrder, true, true>(F.lds + RING_OFF, g, S, E);
        if (rp_ == 0) convert_dn(F, args, F.ctl + CW_Q + 36);
        REPBAR(6); if (BOTH(6)) GRID_BAR();
    }
    if (IN(7)) REP(7) {
        pg8::Gemm g{(const bf16*)(ws + WS_HID), (const bf16*)(ws + WS_WDN), MP, DM, DFF}; pg8::StaticOrder S; S.init(MP, DM, F.G, (int)blockIdx.x, 4);
        pg8::EpiBf16Plain E{(bf16*)(ws + WS_Y2), DM};
        pg8::gemm_phase<pg8::EpiBf16Plain, pg8::StaticOrder, true, true>(F.lds + RING_OFF, g, S, E);
        for (int tn = (int)blockIdx.x; tn < 2 * (DM / 16); tn += F.G) {
            bf16* Y = (bf16*)(ws + WS_Y2);
            auto Et = [=](int tok, int n, float a, float) { Y[(size_t)(MP + tok) * DM + n] = (bf16)f2bf(a); };
            th::tile<DFF, 1>(F.lds + RING_OFF, (const bf16*)(ws + WS_HID) + (size_t)MP * DFF, (const bf16*)(ws + WS_WDN), nullptr, nullptr, 32 * (tn & 1), 16 * (tn >> 1), Et);
        }
        REPBAR(7); if (BOTH(7)) GRID_BAR();
    }
    if (IN(8)) REP(8) { row_pass2(F, args); REPBAR(8); }
#undef IN
#undef BOTH
#undef GRID_BAR
}
extern "C" void kernel_launch(void* const* d_in, const int* in_sizes, int n_in, void* d_out, int out_size, void* d_ws, size_t ws_size, hipStream_t stream) {
    static int grid = 0;
    if (grid == 0) {
        if (n_in != 24 || in_sizes[0] != MP * DM || (size_t)out_size != O_END || ws_size < WS_END) { fprintf(stderr, "kernel_launch: unexpected shapes (n_in %d, in0 %d, out %d, ws %zu); nothing launched\n", n_in, n_in > 0 ? in_sizes[0] : -1, out_size, ws_size); grid = -1; return; }
        int dev = 0, cus = 0, per_cu = 0;
        if (hipGetDevice(&dev) != hipSuccess || hipDeviceGetAttribute(&cus, hipDeviceAttributeMultiprocessorCount, dev) != hipSuccess) { grid = -1; return; }
        if (hipFuncSetAttribute((const void*)mk_fwd, hipFuncAttributeMaxDynamicSharedMemorySize, LDS_BYTES) != hipSuccess) { fprintf(stderr, "kernel_launch: hipFuncSetAttribute failed\n"); grid = -1; return; }
        if (hipOccupancyMaxActiveBlocksPerMultiprocessor(&per_cu, (const void*)mk_fwd, NWAVES * 64, LDS_BYTES) != hipSuccess || per_cu < 1) fprintf(stderr, "kernel_launch: note: occupancy query reports %d\n", per_cu);
        (void)hipGetLastError();
        grid = cus;
    }
    if (grid < 0) return;
    (void)hipMemsetAsync((char*)d_ws + WS_CTL, 0, CTL_ZERO_BYTES, stream);
    Args a{};
    for (int i = 0; i < 24; ++i) a.in[i] = (const float*)d_in[i];
    a.page_table = (const int*)d_in[5]; a.out = (float*)d_out; a.ws = (unsigned char*)d_ws;
    a.ph_lo = 0; a.ph_hi = N_PHASES; a.p2mask = 15;
    hipLaunchKernelGGL(mk_fwd, dim3(grid), dim3(NWAVES * 64), LDS_BYTES, stream, a);
#if defined(PROBE_TWICE)
    (void)hipMemsetAsync((char*)d_ws + WS_CTL, 0, CTL_ZERO_BYTES, stream);
    hipLaunchKernelGGL(mk_fwd, dim3(grid), dim3(NWAVES * 64), LDS_BYTES, stream, a);
#endif
#if defined(PROBE_RELAUNCH)
    (void)hipMemsetAsync((char*)d_ws + WS_CTL + 64 * 4, 0, (4096 - 64) * 4, stream);
    a.ph_lo = PROBE_RELAUNCH; a.ph_hi = PROBE_RELAUNCH + 1;
#if defined(PROBE_P2MASK)
    a.p2mask = PROBE_P2MASK;
#endif
    hipLaunchKernelGGL(mk_fwd, dim3(grid), dim3(NWAVES * 64), LDS_BYTES, stream, a);
#endif
}
```
